# Optimizing an MI355X kernel written in HIP

```python
import jax, jax.numpy as jnp
from jax import lax
import numpy as np

D_MODEL = 1024
BATCH = 2
SEQ = 8192
DEPTH = 2

HEAD_DIM = 64
SB_HEADS = 8
MOBA_HEADS = 8
SB_WIDTH = SB_HEADS * HEAD_DIM
MOBA_WIDTH = MOBA_HEADS * HEAD_DIM
SB_Q_BLOCK = 128
MOBA_BLOCK = 256
MOBA_TOPK = 3
MOBA_Q_CHUNK = 128
ROPE_THETA = 500000.0
ROPE_DIM = HEAD_DIM // 4
D_FF = -(-8 * D_MODEL // (3 * 256)) * 256
DEEPNORM_ALPHA = (2 * DEPTH) ** 0.25
DEEPNORM_BETA = (8 * DEPTH) ** -0.25
LN_EPS = 1e-5
IN_COLS = 3 * SB_WIDTH + 3 * MOBA_WIDTH + 2 * D_MODEL

kernel_name = "hybrid_stickbreaking_moba_swiglu_deepnorm"


def layer_norm(x, g, b):
    xf = x.astype(jnp.float32)
    mu = jnp.mean(xf, axis=-1, keepdims=True)
    var = jnp.mean(jnp.square(xf - mu), axis=-1, keepdims=True)
    y = (xf - mu) * lax.rsqrt(var + LN_EPS) * g.astype(jnp.float32) + b.astype(jnp.float32)
    return y.astype(x.dtype)


def partial_rope(x, pos):
    half = ROPE_DIM // 2
    inv_freq = ROPE_THETA ** (-jnp.arange(0, ROPE_DIM, 2, dtype=jnp.float32) / ROPE_DIM)
    ang = pos.astype(jnp.float32)[:, None] * inv_freq[None, :]
    cos, sin = jnp.cos(ang), jnp.sin(ang)
    xf = x.astype(jnp.float32)
    x1, x2, rest = xf[..., :half], xf[..., half:ROPE_DIM], xf[..., ROPE_DIM:]
    out = jnp.concatenate([x1 * cos - x2 * sin, x2 * cos + x1 * sin, rest], axis=-1)
    return out.astype(x.dtype)


def stick_breaking_attention(q, k, v):
    B, H, S, dh = q.shape
    nblk = S // SB_Q_BLOCK
    scale = dh ** -0.5
    kpos = jnp.arange(S)
    qb = q.reshape(B, H, nblk, SB_Q_BLOCK, dh).transpose(2, 0, 1, 3, 4)

    def block(args):
        qi, i = args
        qpos = i * SB_Q_BLOCK + jnp.arange(SB_Q_BLOCK)
        z = jnp.einsum('bhqd,bhkd->bhqk', qi, k).astype(jnp.float32) * scale
        past = kpos[None, :] < qpos[:, None]
        log_keep = jnp.where(past, jax.nn.log_sigmoid(-z), 0.0)
        suffix = lax.cumsum(log_keep, axis=3, reverse=True) - log_keep
        w = jnp.where(past, jnp.exp(jax.nn.log_sigmoid(z) + suffix), 0.0)
        return jnp.einsum('bhqk,bhkd->bhqd', w.astype(v.dtype), v)

    out = lax.map(block, (qb, jnp.arange(nblk)))
    return out.transpose(1, 2, 0, 3, 4).reshape(B, H, S, dh)


def moba_attention(q, k, v):
    B, H, S, dh = q.shape
    nb = -(-S // MOBA_BLOCK)
    pad = nb * MOBA_BLOCK - S
    kp = jnp.pad(k, ((0, 0), (0, 0), (0, pad), (0, 0)))
    vp = jnp.pad(v, ((0, 0), (0, 0), (0, pad), (0, 0)))
    kb = kp.reshape(B, H, nb, MOBA_BLOCK, dh)
    vb = vp.reshape(B, H, nb, MOBA_BLOCK, dh)
    kmean = jnp.mean(kb.astype(jnp.float32), axis=3).astype(k.dtype)
    topk = min(MOBA_TOPK, nb)
    nchunk = S // MOBA_Q_CHUNK
    qc = q.reshape(B, H, nchunk, MOBA_Q_CHUNK, dh).transpose(2, 0, 1, 3, 4)
    bi = jnp.arange(B)[:, None, None, None]
    hi = jnp.arange(H)[None, :, None, None]
    blk_ids = jnp.arange(nb)
    scale = dh ** -0.5

    def chunk(args):
        qi, c = args
        qpos = c * MOBA_Q_CHUNK + jnp.arange(MOBA_Q_CHUNK)
        own = (c * MOBA_Q_CHUNK) // MOBA_BLOCK
        gate = jnp.einsum('bhqd,bhnd->bhqn', qi, kmean).astype(jnp.float32)
        gate = jnp.where(blk_ids < own, gate, -jnp.inf)
        _, idx = lax.top_k(gate, topk)
        valid = idx < own
        k_sel = kb[bi, hi, idx]
        v_sel = vb[bi, hi, idx]
        s_sel = jnp.einsum('bhqd,bhqnkd->bhqnk', qi, k_sel).astype(jnp.float32) * scale
        s_sel = jnp.where(valid[..., None], s_sel, -jnp.inf).reshape(B, H, MOBA_Q_CHUNK, topk * MOBA_BLOCK)
        k_own = lax.dynamic_slice_in_dim(kb, own, 1, axis=2)[:, :, 0]
        v_own = lax.dynamic_slice_in_dim(vb, own, 1, axis=2)[:, :, 0]
        s_own = jnp.einsum('bhqd,bhkd->bhqk', qi, k_own).astype(jnp.float32) * scale
        own_pos = own * MOBA_BLOCK + jnp.arange(MOBA_BLOCK)
        s_own = jnp.where(own_pos[None, :] <= qpos[:, None], s_own, -jnp.inf)
        p = jax.nn.softmax(jnp.concatenate([s_sel, s_own], axis=-1), axis=-1).astype(v.dtype)
        p_sel = p[..., :topk * MOBA_BLOCK].reshape(B, H, MOBA_Q_CHUNK, topk, MOBA_BLOCK)
        p_own = p[..., topk * MOBA_BLOCK:]
        return (jnp.einsum('bhqnk,bhqnkd->bhqd', p_sel, v_sel)
                + jnp.einsum('bhqk,bhkd->bhqd', p_own, v_own))

    out = lax.map(chunk, (qc, jnp.arange(nchunk)))
    return out.transpose(1, 2, 0, 3, 4).reshape(B, H, S, dh)


def heads(t, n_heads):
    B, S, _ = t.shape
    return t.reshape(B, S, n_heads, HEAD_DIM).transpose(0, 2, 1, 3)


def merge_heads(t):
    B, H, S, dh = t.shape
    return t.transpose(0, 2, 1, 3).reshape(B, S, H * dh)


def hybrid_mixer(x, w_in, w_branch_sb, w_branch_moba, w_out):
    S = x.shape[1]
    proj = x @ w_in
    cuts = np.cumsum([SB_WIDTH, SB_WIDTH, SB_WIDTH, MOBA_WIDTH, MOBA_WIDTH, MOBA_WIDTH, D_MODEL]).tolist()
    q_sb, k_sb, v_sb, q_mb, k_mb, v_mb, g_sb, g_mb = jnp.split(proj, cuts, axis=-1)
    pos = jnp.arange(S)
    o_sb = stick_breaking_attention(heads(q_sb, SB_HEADS), heads(k_sb, SB_HEADS), heads(v_sb, SB_HEADS))
    o_mb = moba_attention(partial_rope(heads(q_mb, MOBA_HEADS), pos),
                          partial_rope(heads(k_mb, MOBA_HEADS), pos),
                          heads(v_mb, MOBA_HEADS))
    branch_sb = merge_heads(o_sb) @ w_branch_sb
    branch_mb = merge_heads(o_mb) @ w_branch_moba
    merged = jax.nn.sigmoid(g_sb) * branch_sb + jax.nn.sigmoid(g_mb) * branch_mb
    return merged @ w_out


def swiglu(x, w_gate, w_up, w_down):
    return (jax.nn.silu(x @ w_gate) * (x @ w_up)) @ w_down


def setup_inputs(seed: int = 0) -> dict:
    key = jax.random.key(seed)
    ks = jax.random.split(key, 12)
    nrm = lambda k, shape, s: jax.random.normal(k, shape, jnp.float32) * s
    L = DEPTH
    return {
        "x": jax.random.normal(ks[0], (BATCH, SEQ, D_MODEL), jnp.float32),
        "w_in": nrm(ks[1], (L, D_MODEL, IN_COLS), D_MODEL ** -0.5),
        "w_branch_sb": nrm(ks[2], (L, SB_WIDTH, D_MODEL), SB_WIDTH ** -0.5),
        "w_branch_moba": nrm(ks[3], (L, MOBA_WIDTH, D_MODEL), MOBA_WIDTH ** -0.5),
        "w_out": nrm(ks[4], (L, D_MODEL, D_MODEL), D_MODEL ** -0.5 * DEEPNORM_BETA),
        "ln_mix_g": 1.0 + nrm(ks[5], (L, D_MODEL), 0.02),
        "ln_mix_b": nrm(ks[6], (L, D_MODEL), 0.02),
        "w_ffn_gate": nrm(ks[7], (L, D_MODEL, D_FF), D_MODEL ** -0.5),
        "w_ffn_up": nrm(ks[8], (L, D_MODEL, D_FF), D_MODEL ** -0.5),
        "w_ffn_down": nrm(ks[9], (L, D_FF, D_MODEL), D_FF ** -0.5 * DEEPNORM_BETA),
        "ln_ffn_g": 1.0 + nrm(ks[10], (L, D_MODEL), 0.02),
        "ln_ffn_b": nrm(ks[11], (L, D_MODEL), 0.02),
    }


def reference(x, w_in, w_branch_sb, w_branch_moba, w_out, ln_mix_g, ln_mix_b,
              w_ffn_gate, w_ffn_up, w_ffn_down, ln_ffn_g, ln_ffn_b):
    for l in range(DEPTH):
        mix = hybrid_mixer(x, w_in[l], w_branch_sb[l], w_branch_moba[l], w_out[l])
        x = layer_norm(DEEPNORM_ALPHA * x + mix, ln_mix_g[l], ln_mix_b[l])
        ffn = swiglu(x, w_ffn_gate[l], w_ffn_up[l], w_ffn_down[l])
        x = layer_norm(DEEPNORM_ALPHA * x + ffn, ln_ffn_g[l], ln_ffn_b[l])
    return x
```

```cpp
#include <hip/hip_runtime.h>
#include <hip/hip_cooperative_groups.h>
#include <cstdio>
#include <cstdint>
namespace cg = cooperative_groups;

namespace pg8 {
#define PG8_LAS __attribute__((address_space(3)))
typedef unsigned short bf16_t;
typedef short bf16x8 __attribute__((ext_vector_type(8)));
typedef float f32x4 __attribute__((ext_vector_type(4)));
typedef float f32x2 __attribute__((ext_vector_type(2)));
typedef unsigned u32x4 __attribute__((ext_vector_type(4)));
constexpr int BM = 256, BK = 64, HALF = 128, HTB = HALF * BK * 2, STAGE_BYTES = 8 * HTB, NXCD = 8, WGM = 8;

__host__ __device__ __forceinline__ int lds_byte(int r, int c) { const int st = (r >> 4) * 2 + (c >> 5), rr = r & 15, cc = c & 31, ob = rr * 64 + cc * 2; return st * 1024 + (ob ^ (((ob >> 9) & 1) << 5)); }
__host__ __device__ __forceinline__ void stage_rc(int b, int& R, int& C) { const int st = b / 1024, sb = b % 1024, swz = sb ^ (((sb >> 9) & 1) << 5); R = (st >> 1) * 16 + swz / 64; C = (st & 1) * 32 + (swz % 64) / 2; }
__host__ __device__ __forceinline__ int perm32(int rho) { const int n = rho >> 4, i = rho & 15; return 8 * (i >> 2) + 4 * n + (i & 3); }

struct Unit { int pm, pn; };
struct Gemm { const bf16_t* A; const bf16_t* Bt; int M, N, K; };

struct StaticOrder {
    int nM, nN, nwg, G, c;
    __host__ __device__ void init(int M, int N, int G_, int c_) { nM = M / BM; nN = N / BM; nwg = nM * nN; G = G_; c = c_; }
    __host__ __device__ bool next(int i, Unit& u) const {
        const long L = (long)i * G + c; if (L >= nwg) return false;
        int wgid = (int)L; { const int q = nwg / NXCD, r = nwg % NXCD, xcd = wgid % NXCD, off = wgid / NXCD; wgid = (xcd < r ? xcd * (q + 1) : r * (q + 1) + (xcd - r) * q) + off; }
        const int nig = WGM * nN, gid = wgid / nig, fm = gid * WGM, gsz = (nM - fm) < WGM ? (nM - fm) : WGM;
        u.pm = fm + ((wgid % nig) % gsz); u.pn = (wgid % nig) / gsz; return true;
    }
};

__device__ __forceinline__ unsigned cvt_pk_bf16(float lo, float hi) { unsigned r; asm volatile("v_cvt_pk_bf16_f32 %0, %1, %2" : "=v"(r) : "v"(lo), "v"(hi)); return r; }
__device__ __forceinline__ float bf_lo(unsigned w) { return __uint_as_float(w << 16); }
__device__ __forceinline__ float bf_hi(unsigned w) { return __uint_as_float(w & 0xffff0000u); }
__device__ __forceinline__ float sigmoidf_(float x) { return 1.0f / (1.0f + __expf(-x)); }

typedef f32x4 Acc[2][2][4][2];

struct EpiBf16 {
    static constexpr bool PERM = true, MID = false;
    bf16_t* O; int ldc;
    __device__ __forceinline__ void mid(Acc&, const Unit&, int, int, int, int) const {}
    __device__ __forceinline__ void operator()(Acc& acc, const Unit& u, int wr, int wc, int fr, int fq) const {
        const int row0 = u.pm * BM + wr * 64 + fr, col0 = u.pn * BM + wc * 32 + 8 * fq;
#pragma unroll
        for (int ai = 0; ai < 2; ++ai)
#pragma unroll
            for (int m = 0; m < 4; ++m) { bf16_t* rowp = O + (size_t)(row0 + ai * HALF + m * 16) * ldc + col0;
#pragma unroll
                for (int bj = 0; bj < 2; ++bj) { const f32x4 v0 = acc[ai][bj][m][0], v1 = acc[ai][bj][m][1];
                    u32x4 w; w.x = cvt_pk_bf16(v0[0], v0[1]); w.y = cvt_pk_bf16(v0[2], v0[3]); w.z = cvt_pk_bf16(v1[0], v1[1]); w.w = cvt_pk_bf16(v1[2], v1[3]);
                    *(u32x4*)(rowp + bj * HALF) = w; } }
    }
};

struct EpiInProj {
    static constexpr bool PERM = true, MID = false;
    bf16_t* QK; bf16_t* G; const float* rope; float* kpart;
    __device__ __forceinline__ void mid(Acc&, const Unit&, int, int, int, int) const {}
    __device__ __forceinline__ void operator()(Acc& acc, const Unit& u, int wr, int wc, int fr, int fq) const {
        const int pn = u.pn, seg = pn >> 1;
        const int row0 = u.pm * BM + wr * 64 + fr;
        bf16_t* base = pn < 8 ? QK : G; const int colt = (pn < 8 ? pn : pn - 8) * BM;
        const int col0 = colt + wc * 32 + 8 * fq;
        const float sc = (pn < 8 && (seg == 0 || seg == 2)) ? 0.125f : 1.0f;
        const bool do_rope = pn >= 4 && pn < 8 && (wc & 1) == 0;
        const bool do_sum = pn >= 6 && pn < 8;
        f32x4 cs_[2][2];
#pragma unroll
        for (int bj = 0; bj < 2; ++bj)
#pragma unroll
            for (int n = 0; n < 2; ++n) cs_[bj][n] = (f32x4){0.f, 0.f, 0.f, 0.f};
#pragma unroll
        for (int ai = 0; ai < 2; ++ai)
#pragma unroll
            for (int m = 0; m < 4; ++m) { const int row = row0 + ai * HALF + m * 16;
                if (do_rope) { const f32x4* cs = (const f32x4*)(rope + (size_t)(row & 8191) * 16);
                    const f32x4 c0 = cs[0], c1 = cs[1], c2 = cs[2], c3 = cs[3];
                    const f32x4 cosA = {c0[0], c0[2], c1[0], c1[2]}, cosB = {c2[0], c2[2], c3[0], c3[2]}, sinA = {c0[1], c0[3], c1[1], c1[3]}, sinB = {c2[1], c2[3], c3[1], c3[3]};
#pragma unroll
                    for (int bj = 0; bj < 2; ++bj)
#pragma unroll
                        for (int n = 0; n < 2; ++n) { const f32x4 v = acc[ai][bj][m][n]; f32x4 p;
#pragma unroll
                            for (int i = 0; i < 4; ++i) p[i] = __shfl_xor(v[i], 16);
                            const f32x4 c = n == 0 ? cosA : cosB, sn = n == 0 ? sinA : sinB;
                            const f32x4 r = fq == 0 ? v * c - p * sn : v * c + p * sn;
                            if (fq < 2) acc[ai][bj][m][n] = r; } }
                bf16_t* rowp = base + (size_t)row * 2048 + col0;
#pragma unroll
                for (int bj = 0; bj < 2; ++bj) { cs_[bj][0] += acc[ai][bj][m][0]; cs_[bj][1] += acc[ai][bj][m][1];
                    const f32x4 v0 = acc[ai][bj][m][0] * sc, v1 = acc[ai][bj][m][1] * sc;
                    u32x4 w; w.x = cvt_pk_bf16(v0[0], v0[1]); w.y = cvt_pk_bf16(v0[2], v0[3]); w.z = cvt_pk_bf16(v1[0], v1[1]); w.w = cvt_pk_bf16(v1[2], v1[3]);
                    *(u32x4*)(rowp + bj * HALF) = w; }
                asm volatile("" ::: "memory"); }
        if (do_sum) {
#pragma unroll
            for (int bj = 0; bj < 2; ++bj)
#pragma unroll
                for (int n = 0; n < 2; ++n) { f32x4 s = cs_[bj][n];
#pragma unroll
                    for (int i = 0; i < 4; ++i) { float t = s[i]; t += __shfl_xor(t, 1); t += __shfl_xor(t, 2); t += __shfl_xor(t, 4); t += __shfl_xor(t, 8); s[i] = t; }
                    if (fr == 0) *(f32x4*)(kpart + ((size_t)u.pm * 2 + wr) * 512 + (pn - 6) * BM + bj * HALF + wc * 32 + 8 * fq + 4 * n) = s; }
        }
    }
};

struct EpiMerged {
    static constexpr bool PERM = true, MID = true;
    const bf16_t* G; bf16_t* O;
    __device__ __forceinline__ void mid(Acc& acc, const Unit& u, int wr, int wc, int fr_, int fq) const {
        int fr = fr_; asm volatile("" : "+v"(fr));
        const int row0 = u.pm * BM + wr * 64 + fr, col0 = u.pn * BM + wc * 32 + 8 * fq;
#pragma unroll
        for (int ai = 0; ai < 2; ++ai)
#pragma unroll
            for (int m = 0; m < 4; ++m) { const bf16_t* gp = G + (size_t)(row0 + ai * HALF + m * 16) * 2048 + col0;
#pragma unroll
                for (int bj = 0; bj < 2; ++bj) { const u32x4 a = *(const u32x4*)(gp + bj * HALF), b = *(const u32x4*)(gp + 1024 + bj * HALF);
#pragma unroll
                    for (int j = 0; j < 4; ++j) { const float a0 = bf_lo(a[j]), a1 = bf_hi(a[j]), b0 = fmaxf(bf_lo(b[j]), -60.f), b1 = fmaxf(bf_hi(b[j]), -60.f);
                        const float r0 = sigmoidf_(a0) * (1.0f + __expf(-b0)), r1 = sigmoidf_(a1) * (1.0f + __expf(-b1));
                        acc[ai][bj][m][j >> 1][(j & 1) * 2] *= r0; acc[ai][bj][m][j >> 1][(j & 1) * 2 + 1] *= r1; } }
                asm volatile("" ::: "memory"); }
    }
    __device__ __forceinline__ void operator()(Acc& acc, const Unit& u, int wr, int wc, int fr, int fq) const {
        const int row0 = u.pm * BM + wr * 64 + fr, col0 = u.pn * BM + wc * 32 + 8 * fq;
#pragma unroll
        for (int ai = 0; ai < 2; ++ai)
#pragma unroll
            for (int m = 0; m < 4; ++m) { const size_t r = (size_t)(row0 + ai * HALF + m * 16);
#pragma unroll
                for (int bj = 0; bj < 2; ++bj) { const u32x4 b = *(const u32x4*)(G + r * 2048 + 1024 + col0 + bj * HALF);
                    float o[8];
#pragma unroll
                    for (int j = 0; j < 4; ++j) { const float b0 = fmaxf(bf_lo(b[j]), -60.f), b1 = fmaxf(bf_hi(b[j]), -60.f);
                        o[2 * j] = acc[ai][bj][m][j >> 1][(j & 1) * 2] * sigmoidf_(b0); o[2 * j + 1] = acc[ai][bj][m][j >> 1][(j & 1) * 2 + 1] * sigmoidf_(b1); }
                    u32x4 w; w.x = cvt_pk_bf16(o[0], o[1]); w.y = cvt_pk_bf16(o[2], o[3]); w.z = cvt_pk_bf16(o[4], o[5]); w.w = cvt_pk_bf16(o[6], o[7]);
                    *(u32x4*)(O + r * 1024 + col0 + bj * HALF) = w; }
                asm volatile("" ::: "memory"); }
    }
};

struct EpiResid {
    static constexpr bool PERM = false, MID = false;
    const float* X; float* Y; float alpha;
    __device__ __forceinline__ void mid(Acc&, const Unit&, int, int, int, int) const {}
    __device__ __forceinline__ void operator()(Acc& acc, const Unit& u, int wr, int wc, int fr, int fq) const {
        const int row0 = u.pm * BM + wr * 64 + fr, col0 = u.pn * BM + wc * 32 + 4 * fq;
#pragma unroll
        for (int ai = 0; ai < 2; ++ai)
#pragma unroll
            for (int m = 0; m < 4; ++m) { const size_t off = (size_t)(row0 + ai * HALF + m * 16) * 1024 + col0;
#pragma unroll
                for (int bj = 0; bj < 2; ++bj)
#pragma unroll
                    for (int n = 0; n < 2; ++n) { const f32x4 x = *(const f32x4*)(X + off + bj * HALF + n * 16);
                        *(f32x4*)(Y + off + bj * HALF + n * 16) = x * alpha + acc[ai][bj][m][n]; } }
    }
};

struct EpiSwiglu {
    static constexpr bool PERM = true, MID = false;
    bf16_t* H;
    __device__ __forceinline__ void mid(Acc&, const Unit&, int, int, int, int) const {}
    __device__ __forceinline__ void operator()(Acc& acc, const Unit& u, int wr, int wc, int fr, int fq) const {
        const int row0 = u.pm * BM + wr * 64 + fr, col0 = u.pn * HALF + wc * 32 + 8 * fq;
#pragma unroll
        for (int ai = 0; ai < 2; ++ai)
#pragma unroll
            for (int m = 0; m < 4; ++m) { float o[8];
#pragma unroll
                for (int n = 0; n < 2; ++n)
#pragma unroll
                    for (int i = 0; i < 4; ++i) { const float g = acc[ai][0][m][n][i], up = acc[ai][1][m][n][i]; o[4 * n + i] = g * sigmoidf_(g) * up; }
                u32x4 w; w.x = cvt_pk_bf16(o[0], o[1]); w.y = cvt_pk_bf16(o[2], o[3]); w.z = cvt_pk_bf16(o[4], o[5]); w.w = cvt_pk_bf16(o[6], o[7]);
                *(u32x4*)(H + (size_t)(row0 + ai * HALF + m * 16) * 2816 + col0) = w; }
    }
};

template <class Epi, bool ALIGN_EPI>
__device__ __forceinline__ void gemm_phase(PG8_LAS unsigned char* lds, const Gemm g, const StaticOrder& S, const Epi& E) {
    int tid_ = threadIdx.x; asm volatile("" : "+v"(tid_));
    const int tid = tid_, wid = __builtin_amdgcn_readfirstlane(tid >> 6), lane = tid & 63, wr = wid >> 2, wc = wid & 3, fr = lane & 15, fq = lane >> 4;
    const int K = g.K, nt = K / BK;
    unsigned voffA[2], voffB[2];
#pragma unroll
    for (int i = 0; i < 2; ++i) { int R, C; stage_rc(tid * 16 + i * 8192, R, C); const int Rb = Epi::PERM ? ((R & ~31) + perm32(R & 31)) : R;
        voffA[i] = (unsigned)(R * K + C) * 2u; voffB[i] = (unsigned)(Rb * K + C) * 2u; }
    const size_t kstep = (size_t)(BK * 2);
    const size_t hstep = (size_t)HALF * K * 2;
    const size_t tstep = 2 * hstep;
    const unsigned ldsw = (unsigned)wid * 1024u;
    const int aoff = lds_byte(wr * 64 + fr, fq * 8), boff = lds_byte(wc * 32 + fr, fq * 8);
#define PG8_SA(b, h) (((b) * 2 + (h)) * HTB)
#define PG8_SB(b, h) ((4 + (b) * 2 + (h)) * HTB)
#define PG8_STAGE(bufoff, gbase, voff) do { _Pragma("unroll") for (int _i = 0; _i < 2; ++_i) \
        __builtin_amdgcn_global_load_lds((const unsigned*)((const char*)(gbase) + (voff)[_i]), (PG8_LAS unsigned*)(lds + (bufoff) + ldsw + _i * 8192), 16, 0, 0); } while (0)
#define PG8_LDA(dst, b, h) do { _Pragma("unroll") for (int m = 0; m < 4; ++m) _Pragma("unroll") for (int k = 0; k < 2; ++k) dst[m][k] = *(const PG8_LAS bf16x8*)(lds + PG8_SA(b, h) + aoff + m * 2048 + k * 1024); } while (0)
#define PG8_LDB(dst, b, h) do { _Pragma("unroll") for (int n = 0; n < 2; ++n) _Pragma("unroll") for (int k = 0; k < 2; ++k) dst[n][k] = *(const PG8_LAS bf16x8*)(lds + PG8_SB(b, h) + boff + n * 2048 + k * 1024); } while (0)
#define PG8_MMA(ai, bj, At, Bt) do { __builtin_amdgcn_s_setprio(1); _Pragma("unroll") for (int m = 0; m < 4; ++m) _Pragma("unroll") for (int n = 0; n < 2; ++n) _Pragma("unroll") for (int k = 0; k < 2; ++k) \
        acc[ai][bj][m][n] = __builtin_amdgcn_mfma_f32_16x16x32_bf16(Bt[n][k], At[m][k], acc[ai][bj][m][n], 0, 0, 0); __builtin_amdgcn_s_setprio(0); } while (0)
#define PG8_WAIT_V(n) asm volatile("s_waitcnt vmcnt(" #n ")" ::: "memory")
#define PG8_WAIT_L(n) asm volatile("s_waitcnt lgkmcnt(" #n ")" ::: "memory")
#define PG8_BAR __builtin_amdgcn_s_barrier()
#define PG8_SCHED __builtin_amdgcn_sched_barrier(0)
    Unit cur, nxt; int ui = 0;
    if (!S.next(0, cur)) return;
    Acc acc;
#pragma unroll
    for (int a = 0; a < 2; ++a)
#pragma unroll
        for (int b = 0; b < 2; ++b)
#pragma unroll
            for (int m = 0; m < 4; ++m)
#pragma unroll
                for (int n = 0; n < 2; ++n) acc[a][b][m][n] = (f32x4){0.f, 0.f, 0.f, 0.f};
    bf16x8 At[4][2], B0[2][2], B1[2][2];
    const char* cA = (const char*)g.A + (size_t)cur.pm * tstep; const char* cB = (const char*)g.Bt + (size_t)cur.pn * tstep;
    PG8_STAGE(PG8_SB(0, 0), cB, voffB); PG8_STAGE(PG8_SB(0, 1), cB + hstep, voffB); PG8_STAGE(PG8_SA(0, 0), cA, voffA); PG8_STAGE(PG8_SA(0, 1), cA + hstep, voffA);
    if (wr == 1) PG8_BAR;
    PG8_WAIT_V(2); PG8_BAR;
    PG8_STAGE(PG8_SB(1, 0), cB + kstep, voffB); PG8_STAGE(PG8_SA(1, 0), cA + kstep, voffA); PG8_STAGE(PG8_SB(1, 1), cB + hstep + kstep, voffB);
    PG8_WAIT_V(6); PG8_BAR;
    for (;;) {
        const bool has_next = S.next(ui + 1, nxt);
        const char* nA = has_next ? (const char*)g.A + (size_t)nxt.pm * tstep : cA; const char* nB = has_next ? (const char*)g.Bt + (size_t)nxt.pn * tstep : cB;
        for (int t = 0; t < nt; t += 2) {
            if constexpr (Epi::MID) { if (t == nt / 2) E.mid(acc, cur, wr, wc, fr, fq); }
            const bool last = (t == nt - 2);
            const char* a1 = cA + (size_t)(t + 1) * kstep;
            const char* a2 = last ? nA : cA + (size_t)(t + 2) * kstep; const char* b2 = last ? nB : cB + (size_t)(t + 2) * kstep;
            const char* a3 = a2 + kstep; const char* b3 = b2 + kstep;
            PG8_LDB(B0, 0, 0); PG8_LDB(B1, 0, 1); PG8_SCHED; PG8_LDA(At, 0, 0); PG8_STAGE(PG8_SA(1, 1), a1 + hstep, voffA);
            PG8_WAIT_V(8); PG8_WAIT_L(0); PG8_BAR; PG8_MMA(0, 0, At, B0); PG8_MMA(0, 1, At, B1); PG8_BAR; PG8_SCHED;
            PG8_LDA(At, 0, 1); PG8_STAGE(PG8_SB(0, 0), b2, voffB); PG8_STAGE(PG8_SB(0, 1), b2 + hstep, voffB); PG8_STAGE(PG8_SA(0, 0), a2, voffA);
            PG8_WAIT_V(8); PG8_WAIT_L(0); PG8_BAR; PG8_MMA(1, 0, At, B0); PG8_MMA(1, 1, At, B1); PG8_BAR; PG8_SCHED;
            PG8_LDB(B0, 1, 0); PG8_LDB(B1, 1, 1); PG8_SCHED; PG8_LDA(At, 1, 0); PG8_STAGE(PG8_SA(0, 1), a2 + hstep, voffA);
            PG8_WAIT_V(8); PG8_WAIT_L(0); PG8_BAR; PG8_MMA(0, 0, At, B0); PG8_MMA(0, 1, At, B1); PG8_BAR; PG8_SCHED;
            PG8_LDA(At, 1, 1); PG8_STAGE(PG8_SB(1, 0), b3, voffB); PG8_STAGE(PG8_SB(1, 1), b3 + hstep, voffB); PG8_STAGE(PG8_SA(1, 0), a3, voffA);
            PG8_WAIT_V(8); PG8_WAIT_L(0); PG8_BAR; PG8_MMA(1, 0, At, B0); PG8_MMA(1, 1, At, B1); PG8_BAR; PG8_SCHED;
        }
        if constexpr (ALIGN_EPI) { if (wr == 0) PG8_BAR; }
        E(acc, cur, wr, wc, fr, fq);
        if (!has_next) break;
#pragma unroll
        for (int a = 0; a < 2; ++a)
#pragma unroll
            for (int b = 0; b < 2; ++b)
#pragma unroll
                for (int m = 0; m < 4; ++m)
#pragma unroll
                    for (int n = 0; n < 2; ++n) acc[a][b][m][n] = (f32x4){0.f, 0.f, 0.f, 0.f};
        cur = nxt; cA = nA; cB = nB; ++ui;
        if constexpr (ALIGN_EPI) { if (wr == 1) PG8_BAR; }
    }
    PG8_WAIT_V(0);
    if constexpr (!ALIGN_EPI) { if (wr == 0) PG8_BAR; }
    PG8_BAR;
#undef PG8_SA
#undef PG8_SB
#undef PG8_STAGE
#undef PG8_LDA
#undef PG8_LDB
#undef PG8_MMA
#undef PG8_WAIT_V
#undef PG8_WAIT_L
#undef PG8_BAR
#undef PG8_SCHED
}
}

constexpr int NWAVES = 8, NTHREADS = 512;
constexpr int BATCH = 2, SEQ = 8192, D = 1024, M = BATCH * SEQ, DFF = 2816, DEPTH = 2, HD = 64, NH = 8;
constexpr int IN_COLS = 5120;
constexpr float LN_EPS = 1e-5f;
constexpr float ALPHA = 1.41421356237309515f;

typedef unsigned short bf16;
typedef unsigned v4u __attribute__((ext_vector_type(4)));
typedef float f32x4 __attribute__((ext_vector_type(4)));
#define LAS __attribute__((address_space(3)))

constexpr size_t MiB = 1u << 20;
constexpr size_t WS_W = 0, W_LAYER = 31 * MiB;
constexpr size_t WO_MAIN = 0;
constexpr size_t WO_VT = WO_MAIN + (size_t)4096 * 1024 * 2;
constexpr size_t WO_BR = WO_VT + (size_t)1024 * 1024 * 2;
constexpr size_t WO_OUT = WO_BR + (size_t)1024 * 1024 * 2;
constexpr size_t WO_GU = WO_OUT + (size_t)1024 * 1024 * 2;
constexpr size_t WO_DN = WO_GU + (size_t)5632 * 1024 * 2;
static_assert(WO_DN + (size_t)1024 * 2816 * 2 <= W_LAYER, "weights per layer");
constexpr size_t WS_XN = 62 * MiB;
constexpr size_t WS_O = WS_XN;
constexpr size_t WS_QK = 94 * MiB;
constexpr size_t WS_MG = WS_QK, WS_H = WS_QK;
constexpr size_t WS_G = 158 * MiB;
constexpr size_t WS_Y = WS_G;
constexpr size_t WS_Y2 = 182 * MiB;
constexpr size_t WS_VT = 222 * MiB;
constexpr size_t WS_ROPE = 254 * MiB;
constexpr size_t WS_KPART = WS_ROPE + 512 * 1024;
constexpr size_t WS_END = 256 * MiB;
static_assert(WS_H + (size_t)M * DFF * 2 <= WS_Y2 && WS_Y2 + (size_t)M * D * 4 <= WS_ROPE && WS_KPART + 64 * 2 * 512 * 4 <= WS_END, "d_ws map");

constexpr int RING_BYTES = 131072, LDS_BYTES = 147456;

__device__ __forceinline__ unsigned f2bf(float f) { unsigned u = __builtin_bit_cast(unsigned, f); return (u + 0x7fffu + ((u >> 16) & 1u)) >> 16; }
__device__ __forceinline__ unsigned pk2(float lo, float hi) { return f2bf(lo) | (f2bf(hi) << 16); }
__device__ __forceinline__ float bflo(unsigned w) { return __uint_as_float(w << 16); }
__device__ __forceinline__ float bfhi(unsigned w) { return __uint_as_float(w & 0xffff0000u); }
__device__ __forceinline__ float wave_sum(float v) {
#pragma unroll
    for (int o = 1; o < 64; o <<= 1) v += __shfl_xor(v, o);
    return v;
}

__device__ __forceinline__ void transpose_item(const float* W, int N, int kb, int nb, bf16* dst, int row0, int ld, int col_off, LAS float* scr, int lane) {
    const int k0 = 64 * kb, n0 = 32 * nb;
#pragma unroll 8
    for (int i = 0; i < 32; ++i) { const int kk = 2 * i + (lane >> 5); scr[kk * 33 + (lane & 31)] = W[(size_t)(k0 + kk) * N + n0 + (lane & 31)]; }
    asm volatile("s_waitcnt lgkmcnt(0)" ::: "memory");
    const int c = lane & 7;
#pragma unroll
    for (int j = 0; j < 4; ++j) { const int n = (lane >> 3) + 8 * j; const LAS float* s = scr + (8 * c) * 33 + n;
        v4u o; o.x = pk2(s[0 * 33], s[1 * 33]); o.y = pk2(s[2 * 33], s[3 * 33]); o.z = pk2(s[4 * 33], s[5 * 33]); o.w = pk2(s[6 * 33], s[7 * 33]);
        *(v4u*)(dst + (size_t)(row0 + n) * ld + col_off + k0 + 8 * c) = o; }
    asm volatile("s_waitcnt lgkmcnt(0)" ::: "memory");
}

struct Args { const float* in[12]; float* out; unsigned char* ws; };

__device__ __forceinline__ void prologue(const Args& a, LAS unsigned char* lds, int gw, int NGW, int wave, int lane) {
    LAS float* scr = (LAS float*)(lds + wave * 16384);
    constexpr int I_IN = 16 * 160, I_BR = 8 * 32, I_OUT = 16 * 32, I_G = 16 * 88, I_DN = 44 * 32;
    constexpr int PER_LAYER = I_IN + 2 * I_BR + I_OUT + 2 * I_G + I_DN;
    for (int it = gw; it < DEPTH * PER_LAYER; it += NGW) {
        const int l = it / PER_LAYER; int r = it % PER_LAYER;
        unsigned char* wl = a.ws + WS_W + (size_t)l * W_LAYER;
        if (r < I_IN) { const int kb = r / 160, nb = r % 160, c = nb * 32;
            bf16* dst; int row0;
            if (c < 1024) { dst = (bf16*)(wl + WO_MAIN); row0 = c; }
            else if (c < 1536) { dst = (bf16*)(wl + WO_VT); row0 = c - 1024; }
            else if (c < 2560) { dst = (bf16*)(wl + WO_MAIN); row0 = c - 1536 + 1024; }
            else if (c < 3072) { dst = (bf16*)(wl + WO_VT); row0 = c - 2560 + 512; }
            else { dst = (bf16*)(wl + WO_MAIN); row0 = c - 3072 + 2048; }
            transpose_item(a.in[1] + (size_t)l * 1024 * IN_COLS, IN_COLS, kb, nb, dst, row0, 1024, 0, scr, lane); continue; }
        r -= I_IN;
        if (r < I_BR) { transpose_item(a.in[2] + (size_t)l * 512 * 1024, 1024, r / 32, r % 32, (bf16*)(wl + WO_BR), (r % 32) * 32, 1024, 0, scr, lane); continue; }
        r -= I_BR;
        if (r < I_BR) { transpose_item(a.in[3] + (size_t)l * 512 * 1024, 1024, r / 32, r % 32, (bf16*)(wl + WO_BR), (r % 32) * 32, 1024, 512, scr, lane); continue; }
        r -= I_BR;
        if (r < I_OUT) { transpose_item(a.in[4] + (size_t)l * 1024 * 1024, 1024, r / 32, r % 32, (bf16*)(wl + WO_OUT), (r % 32) * 32, 1024, 0, scr, lane); continue; }
        r -= I_OUT;
        if (r < I_G) { const int nb = r % 88, c = nb * 32; transpose_item(a.in[7] + (size_t)l * 1024 * DFF, DFF, r / 88, nb, (bf16*)(wl + WO_GU), 256 * (c / 128) + (c % 128), 1024, 0, scr, lane); continue; }
        r -= I_G;
        if (r < I_G) { const int nb = r % 88, c = nb * 32; transpose_item(a.in[8] + (size_t)l * 1024 * DFF, DFF, r / 88, nb, (bf16*)(wl + WO_GU), 256 * (c / 128) + 128 + (c % 128), 1024, 0, scr, lane); continue; }
        r -= I_G;
        transpose_item(a.in[9] + (size_t)l * DFF * 1024, 1024, r / 32, r % 32, (bf16*)(wl + WO_DN), (r % 32) * 32, DFF, 0, scr, lane);
    }
    bf16* XN = (bf16*)(a.ws + WS_XN);
    for (int m = gw; m < M; m += NGW) { const f32x4* xr = (const f32x4*)(a.in[0] + (size_t)m * D) + lane; unsigned long long* o8 = (unsigned long long*)(XN + (size_t)m * D) + lane;
#pragma unroll
        for (int j = 0; j < 4; ++j) { const f32x4 v = xr[64 * j]; o8[64 * j] = (unsigned long long)pk2(v.x, v.y) | ((unsigned long long)pk2(v.z, v.w) << 32); } }
    float* rope = (float*)(a.ws + WS_ROPE);
    for (int e = gw * 64 + lane; e < SEQ * 8; e += NGW * 64) { const int pos = e >> 3, i = e & 7;
        const double ang = (double)pos * exp(-(double)i * 0.125 * log(500000.0));
        rope[2 * e] = (float)cos(ang); rope[2 * e + 1] = (float)sin(ang); }
}

__device__ __forceinline__ void ln_phase(const float* Y, const float* gam, const float* bet, float* X, bf16* XN, int gw, int NGW, int lane_) {
    int lane = lane_; asm volatile("" : "+v"(lane));
    for (int m = gw; m < M; m += NGW) {
        const f32x4* yr = (const f32x4*)(Y + (size_t)m * D) + lane;
        f32x4 v[4]; float s = 0.f;
#pragma unroll
        for (int j = 0; j < 4; ++j) { v[j] = yr[64 * j]; s += (v[j].x + v[j].y) + (v[j].z + v[j].w); }
        const float mean = wave_sum(s) * (1.f / D); float s2 = 0.f;
#pragma unroll
        for (int j = 0; j < 4; ++j) { v[j] = v[j] - mean; s2 += (v[j].x * v[j].x + v[j].y * v[j].y) + (v[j].z * v[j].z + v[j].w * v[j].w); }
        const float rstd = 1.f / sqrtf(wave_sum(s2) * (1.f / D) + LN_EPS);
        f32x4* xo = (f32x4*)(X + (size_t)m * D) + lane; unsigned long long* o8 = (unsigned long long*)(XN + (size_t)m * D) + lane;
#pragma unroll
        for (int j = 0; j < 4; ++j) { const f32x4 g = ((const f32x4*)gam)[lane + 64 * j], b = ((const f32x4*)bet)[lane + 64 * j];
            const f32x4 o = v[j] * rstd * g + b; xo[64 * j] = o;
            o8[64 * j] = (unsigned long long)pk2(o.x, o.y) | ((unsigned long long)pk2(o.z, o.w) << 32); }
    }
}

__device__ __forceinline__ float dot8(v4u q, v4u k) {
    return bflo(q.x) * bflo(k.x) + bfhi(q.x) * bfhi(k.x) + bflo(q.y) * bflo(k.y) + bfhi(q.y) * bfhi(k.y) + bflo(q.z) * bflo(k.z) + bfhi(q.z) * bfhi(k.z) + bflo(q.w) * bflo(k.w) + bfhi(q.w) * bfhi(k.w);
}
__device__ __forceinline__ float quad_sum(float v) { v += __shfl_xor(v, 1); v += __shfl_xor(v, 2); return v; }
__device__ __forceinline__ void dots8(float* z, v4u q0, v4u q1, const bf16* krow0_) {
    const bf16* krow0 = krow0_; asm volatile("" : "+v"(krow0));
#pragma unroll
    for (int i = 0; i < 8; ++i) { const bf16* kr = krow0 + (size_t)i * 2048;
        z[i] = quad_sum(dot8(q0, *(const v4u*)kr) + dot8(q1, *(const v4u*)(kr + 8))); }
}
__device__ __forceinline__ void accum_v8(float* o, const float* w, const bf16* vcol0_) {
    const bf16* vcol0 = vcol0_; asm volatile("" : "+v"(vcol0));
#pragma unroll
    for (int d = 0; d < 16; ++d) { const v4u v = *(const v4u*)(vcol0 + (size_t)d * M);
        o[d] += w[0] * bflo(v.x) + w[1] * bfhi(v.x) + w[2] * bflo(v.y) + w[3] * bfhi(v.y) + w[4] * bflo(v.z) + w[5] * bfhi(v.z) + w[6] * bflo(v.w) + w[7] * bfhi(v.w); }
}
__device__ __forceinline__ void store_o16(const float* o, float sc, bf16* p) {
#pragma unroll
    for (int c = 0; c < 2; ++c) { v4u w; w.x = pk2(o[8 * c] * sc, o[8 * c + 1] * sc); w.y = pk2(o[8 * c + 2] * sc, o[8 * c + 3] * sc); w.z = pk2(o[8 * c + 4] * sc, o[8 * c + 5] * sc); w.w = pk2(o[8 * c + 6] * sc, o[8 * c + 7] * sc);
        *(v4u*)(p + 8 * c) = w; }
}

__device__ __forceinline__ void sb_thread(const bf16* QK, const bf16* Vt, bf16* O, int b, int h, int q, int part) {
    const size_t row = (size_t)b * SEQ + q;
    const bf16* qp = QK + row * 2048 + h * 64 + part * 16;
    const v4u q0 = *(const v4u*)qp, q1 = *(const v4u*)(qp + 8);
    float o[16];
#pragma unroll
    for (int d = 0; d < 16; ++d) o[d] = 0.f;
    float c = 0.f;
    const bf16* Kb = QK + (size_t)b * SEQ * 2048 + 512 + h * 64 + part * 16;
    const bf16* Vb = Vt + (size_t)(h * 64 + part * 16) * M + (size_t)b * SEQ;
    for (int s0 = (q - 1) & ~7; s0 >= 0 && q > 0; s0 -= 8) {
        float z[8], w[8]; dots8(z, q0, q1, Kb + (size_t)s0 * 2048);
#pragma unroll
        for (int i = 7; i >= 0; --i) {
            const float zz = z[i]; const float l1p = __logf(1.0f + __expf(-fabsf(zz)));
            const float lk = -(fmaxf(zz, 0.f) + l1p), ls = fminf(zz, 0.f) - l1p;
            const bool past = (s0 + i) < q;
            w[i] = past ? __expf(ls + c) : 0.f; c += past ? lk : 0.f; }
        accum_v8(o, w, Vb + s0);
        if (c < -88.0f) break;
    }
    store_o16(o, 1.0f, O + row * 1024 + h * 64 + part * 16);
}

__device__ __forceinline__ void moba_chunk(float* o, float& mrun, float& lrun, v4u q0, v4u q1, const bf16* Kb, const bf16* Vb, int s0, int q) {
    float z[8]; dots8(z, q0, q1, Kb + (size_t)s0 * 2048);
    float mx = -INFINITY;
#pragma unroll
    for (int i = 0; i < 8; ++i) { if (s0 + i > q) z[i] = -INFINITY; mx = fmaxf(mx, z[i]); }
    const float mnew = fmaxf(mrun, mx), al = __expf(mrun - mnew);
    float w[8], ps = 0.f;
#pragma unroll
    for (int i = 0; i < 8; ++i) { w[i] = __expf(z[i] - mnew); ps += w[i]; }
    lrun = lrun * al + ps; mrun = mnew;
#pragma unroll
    for (int d = 0; d < 16; ++d) o[d] *= al;
    accum_v8(o, w, Vb + s0);
}

__device__ __forceinline__ void moba_thread(const bf16* QK, const bf16* Vt, bf16* O, const LAS float* kmean, int b, int h, int q, int part) {
    const size_t row = (size_t)b * SEQ + q;
    const bf16* qp = QK + row * 2048 + 1024 + h * 64 + part * 16;
    const v4u q0 = *(const v4u*)qp, q1 = *(const v4u*)(qp + 8);
    const int own = q >> 8;
    float v1 = -INFINITY, v2 = -INFINITY, v3 = -INFINITY; int i1 = 0, i2 = 0, i3 = 0;
    for (int j = 0; j < own; ++j) { const LAS float* k8 = kmean + j * 64 + part * 16;
        float g = bflo(q0.x) * k8[0] + bfhi(q0.x) * k8[1] + bflo(q0.y) * k8[2] + bfhi(q0.y) * k8[3] + bflo(q0.z) * k8[4] + bfhi(q0.z) * k8[5] + bflo(q0.w) * k8[6] + bfhi(q0.w) * k8[7]
                + bflo(q1.x) * k8[8] + bfhi(q1.x) * k8[9] + bflo(q1.y) * k8[10] + bfhi(q1.y) * k8[11] + bflo(q1.z) * k8[12] + bfhi(q1.z) * k8[13] + bflo(q1.w) * k8[14] + bfhi(q1.w) * k8[15];
        g = quad_sum(g);
        if (g > v1) { v3 = v2; i3 = i2; v2 = v1; i2 = i1; v1 = g; i1 = j; }
        else if (g > v2) { v3 = v2; i3 = i2; v2 = g; i2 = j; }
        else if (g > v3) { v3 = g; i3 = j; } }
    const int nsel = own < 3 ? own : 3;
    float o[16];
#pragma unroll
    for (int d = 0; d < 16; ++d) o[d] = 0.f;
    float mrun = -INFINITY, lrun = 0.f;
    const bf16* Kb = QK + (size_t)b * SEQ * 2048 + 1536 + h * 64 + part * 16;
    const bf16* Vb = Vt + (size_t)(512 + h * 64 + part * 16) * M + (size_t)b * SEQ;
    for (int t = 0; t < nsel; ++t) { const int blk = t == 0 ? i1 : (t == 1 ? i2 : i3);
        for (int s0 = blk * 256; s0 < blk * 256 + 256; s0 += 8) moba_chunk(o, mrun, lrun, q0, q1, Kb, Vb, s0, q); }
    for (int s0 = own * 256; s0 <= q; s0 += 8) moba_chunk(o, mrun, lrun, q0, q1, Kb, Vb, s0, q);
    store_o16(o, 1.0f / lrun, O + row * 1024 + 512 + h * 64 + part * 16);
}

__device__ __forceinline__ void attn_phase_v1(const Args& a, LAS unsigned char* lds, int G) {
    const bf16* QK = (const bf16*)(a.ws + WS_QK); const bf16* Vt = (const bf16*)(a.ws + WS_VT); bf16* O = (bf16*)(a.ws + WS_O);
    const float* kpart = (const float*)(a.ws + WS_KPART);
    LAS float* kmean = (LAS float*)lds;
    for (int u = blockIdx.x; u < 256; u += G) {
        int tq = threadIdx.x; asm volatile("" : "+v"(tq));
        const int bh = u >> 4, b = bh >> 3, h = bh & 7;
        __syncthreads();
        for (int e = tq; e < 32 * 64; e += NTHREADS) { const int j = e >> 6, d = e & 63; const float* kp = kpart + ((size_t)(b * 32 + j) * 2) * 512 + h * 64 + d;
            kmean[e] = (kp[0] + kp[512]) * (1.0f / 256.0f); }
        __syncthreads();
        for (int pass = 0; pass < 4; ++pass) { const int q = (u & 15) * 512 + pass * 128 + (tq >> 2), part = tq & 3;
            sb_thread(QK, Vt, O, b, h, q, part);
            moba_thread(QK, Vt, O, kmean, b, h, q, part); }
    }
}

__global__ void __launch_bounds__(NTHREADS, 2) fwd_megakernel(Args a) {
    extern __shared__ __attribute__((aligned(16))) unsigned char lds_raw[];
    LAS unsigned char* lds = (LAS unsigned char*)lds_raw;
    cg::grid_group grid = cg::this_grid();
    const int tid = threadIdx.x, lane = tid & 63, wave = __builtin_amdgcn_readfirstlane(tid >> 6);
    const int G = gridDim.x, gw = blockIdx.x * NWAVES + wave, NGW = G * NWAVES;
    unsigned char* ws = a.ws;
    bf16* XN = (bf16*)(ws + WS_XN); bf16* QK = (bf16*)(ws + WS_QK); bf16* Gt = (bf16*)(ws + WS_G); bf16* Vt = (bf16*)(ws + WS_VT); bf16* O = (bf16*)(ws + WS_O);
    bf16* MG = (bf16*)(ws + WS_MG); bf16* H = (bf16*)(ws + WS_H); float* Y = (float*)(ws + WS_Y); float* Y2 = (float*)(ws + WS_Y2);
    float* rope = (float*)(ws + WS_ROPE); float* kpart = (float*)(ws + WS_KPART);

    prologue(a, lds, gw, NGW, wave, lane);
    grid.sync();

    for (int l = 0; l < DEPTH; ++l) {
        const unsigned char* wl = ws + WS_W + (size_t)l * W_LAYER;
        const float* Xres = l == 0 ? a.in[0] : a.out;
        { pg8::Gemm g{XN, (const bf16*)(wl + WO_MAIN), M, 4096, 1024}; pg8::StaticOrder S; S.init(M, 4096, G, (int)blockIdx.x);
          pg8::EpiInProj E{QK, Gt, rope, kpart};
          pg8::gemm_phase<pg8::EpiInProj, true>(lds, g, S, E); }
        { pg8::Gemm g{(const bf16*)(wl + WO_VT), XN, 1024, M, 1024}; pg8::StaticOrder S; S.init(1024, M, G, (int)blockIdx.x);
          pg8::EpiBf16 E{Vt, M};
          pg8::gemm_phase<pg8::EpiBf16, true>(lds, g, S, E); }
        grid.sync();
        attn_phase_v1(a, lds, G);
        grid.sync();
        { pg8::Gemm g{O, (const bf16*)(wl + WO_BR), M, 1024, 1024}; pg8::StaticOrder S; S.init(M, 1024, G, (int)blockIdx.x);
          pg8::EpiMerged E{Gt, MG};
          pg8::gemm_phase<pg8::EpiMerged, false>(lds, g, S, E); }
        grid.sync();
        { pg8::Gemm g{MG, (const bf16*)(wl + WO_OUT), M, 1024, 1024}; pg8::StaticOrder S; S.init(M, 1024, G, (int)blockIdx.x);
          pg8::EpiResid E{Xres, Y, ALPHA};
          pg8::gemm_phase<pg8::EpiResid, false>(lds, g, S, E); }
        grid.sync();
        ln_phase(Y, a.in[5] + (size_t)l * D, a.in[6] + (size_t)l * D, a.out, XN, gw, NGW, lane);
        grid.sync();
        { pg8::Gemm g{XN, (const bf16*)(wl + WO_GU), M, 2 * DFF, 1024}; pg8::StaticOrder S; S.init(M, 2 * DFF, G, (int)blockIdx.x);
          pg8::EpiSwiglu E{H};
          pg8::gemm_phase<pg8::EpiSwiglu, true>(lds, g, S, E); }
        grid.sync();
        { pg8::Gemm g{H, (const bf16*)(wl + WO_DN), M, 1024, DFF}; pg8::StaticOrder S; S.init(M, 1024, G, (int)blockIdx.x);
          pg8::EpiResid E{a.out, Y2, ALPHA};
          pg8::gemm_phase<pg8::EpiResid, false>(lds, g, S, E); }
        grid.sync();
        ln_phase(Y2, a.in[10] + (size_t)l * D, a.in[11] + (size_t)l * D, a.out, XN, gw, NGW, lane);
        if (l + 1 < DEPTH) grid.sync();
    }
}

extern "C" void kernel_launch(void* const* d_in, const int* in_sizes, int n_in, void* d_out, int out_size, void* d_ws, size_t ws_size, hipStream_t stream) {
    static int grid = 0;
    if (grid == 0) {
        if (n_in != 12 || in_sizes[0] != M * D || out_size != M * D || ws_size < WS_END) { fprintf(stderr, "kernel_launch: unexpected problem shape (n_in %d, ws %zu); nothing launched\n", n_in, ws_size); grid = -1; return; }
        int dev = 0, cus = 0, per_cu = 0;
        if (hipGetDevice(&dev) != hipSuccess || hipDeviceGetAttribute(&cus, hipDeviceAttributeMultiprocessorCount, dev) != hipSuccess) { grid = -1; return; }
        if (hipFuncSetAttribute((const void*)fwd_megakernel, hipFuncAttributeMaxDynamicSharedMemorySize, LDS_BYTES) != hipSuccess) { fprintf(stderr, "kernel_launch: hipFuncSetAttribute failed\n"); grid = -1; return; }
        if (hipOccupancyMaxActiveBlocksPerMultiprocessor(&per_cu, (const void*)fwd_megakernel, NTHREADS, LDS_BYTES) != hipSuccess || per_cu < 1) per_cu = 1;
        (void)hipGetLastError();
        grid = cus;
        (void)per_cu;
    }
    if (grid < 0) return;
    Args a{};
    for (int i = 0; i < 12; ++i) a.in[i] = (const float*)d_in[i];
    a.out = (float*)d_out; a.ws = (unsigned char*)d_ws;
    void* args[] = {&a};
    hipError_t e = hipLaunchCooperativeKernel((const void*)fwd_megakernel, dim3(grid), dim3(NTHREADS), args, LDS_BYTES, stream);
    if (e != hipSuccess) fprintf(stderr, "cooperative launch failed: %s (grid %d)\n", hipGetErrorString(e), grid);
}
```

```cpp
#include <hip/hip_runtime.h>
#include <hip/hip_cooperative_groups.h>
#include <cstdio>
#include <cstdint>
namespace cg = cooperative_groups;

namespace pg8 {
#define PG8_LAS __attribute__((address_space(3)))
typedef unsigned short bf16_t;
typedef short bf16x8 __attribute__((ext_vector_type(8)));
typedef float f32x4 __attribute__((ext_vector_type(4)));
typedef float f32x2 __attribute__((ext_vector_type(2)));
typedef unsigned u32x4 __attribute__((ext_vector_type(4)));
constexpr int BM = 256, BK = 64, HALF = 128, HTB = HALF * BK * 2, STAGE_BYTES = 8 * HTB, NXCD = 8, WGM = 8;

__host__ __device__ __forceinline__ int lds_byte(int r, int c) { const int st = (r >> 4) * 2 + (c >> 5), rr = r & 15, cc = c & 31, ob = rr * 64 + cc * 2; return st * 1024 + (ob ^ (((ob >> 9) & 1) << 5)); }
__host__ __device__ __forceinline__ void stage_rc(int b, int& R, int& C) { const int st = b / 1024, sb = b % 1024, swz = sb ^ (((sb >> 9) & 1) << 5); R = (st >> 1) * 16 + swz / 64; C = (st & 1) * 32 + (swz % 64) / 2; }
__host__ __device__ __forceinline__ int perm32(int rho) { const int n = rho >> 4, i = rho & 15; return 8 * (i >> 2) + 4 * n + (i & 3); }

struct Unit { int pm, pn; };
struct Gemm { const bf16_t* A; const bf16_t* Bt; int M, N, K; };

struct StaticOrder {
    int nM, nN, nwg, G, c;
    __host__ __device__ void init(int M, int N, int G_, int c_) { nM = M / BM; nN = N / BM; nwg = nM * nN; G = G_; c = c_; }
    __host__ __device__ bool next(int i, Unit& u) const {
        const long L = (long)i * G + c; if (L >= nwg) return false;
        int wgid = (int)L; { const int q = nwg / NXCD, r = nwg % NXCD, xcd = wgid % NXCD, off = wgid / NXCD; wgid = (xcd < r ? xcd * (q + 1) : r * (q + 1) + (xcd - r) * q) + off; }
        const int nig = WGM * nN, gid = wgid / nig, fm = gid * WGM, gsz = (nM - fm) < WGM ? (nM - fm) : WGM;
        u.pm = fm + ((wgid % nig) % gsz); u.pn = (wgid % nig) / gsz; return true;
    }
};

__device__ __forceinline__ unsigned cvt_pk_bf16(float lo, float hi) { unsigned r; asm volatile("v_cvt_pk_bf16_f32 %0, %1, %2" : "=v"(r) : "v"(lo), "v"(hi)); return r; }
__device__ __forceinline__ float bf_lo(unsigned w) { return __uint_as_float(w << 16); }
__device__ __forceinline__ float bf_hi(unsigned w) { return __uint_as_float(w & 0xffff0000u); }
__device__ __forceinline__ float sigmoidf_(float x) { return 1.0f / (1.0f + __expf(-x)); }

typedef f32x4 Acc[2][2][4][2];

struct EpiBf16 {
    static constexpr bool PERM = true, MID = false;
    bf16_t* O; int ldc;
    __device__ __forceinline__ void mid(Acc&, const Unit&, int, int, int, int) const {}
    __device__ __forceinline__ void operator()(Acc& acc, const Unit& u, int wr, int wc, int fr, int fq) const {
        const int row0 = u.pm * BM + wr * 64 + fr, col0 = u.pn * BM + wc * 32 + 8 * fq;
#pragma unroll
        for (int ai = 0; ai < 2; ++ai)
#pragma unroll
            for (int m = 0; m < 4; ++m) { bf16_t* rowp = O + (size_t)(row0 + ai * HALF + m * 16) * ldc + col0;
#pragma unroll
                for (int bj = 0; bj < 2; ++bj) { const f32x4 v0 = acc[ai][bj][m][0], v1 = acc[ai][bj][m][1];
                    u32x4 w; w.x = cvt_pk_bf16(v0[0], v0[1]); w.y = cvt_pk_bf16(v0[2], v0[3]); w.z = cvt_pk_bf16(v1[0], v1[1]); w.w = cvt_pk_bf16(v1[2], v1[3]);
                    *(u32x4*)(rowp + bj * HALF) = w; } }
    }
};

struct EpiInProj {
    static constexpr bool PERM = true, MID = false;
    bf16_t* QK; bf16_t* G; const float* rope; float* kpart;
    __device__ __forceinline__ void mid(Acc&, const Unit&, int, int, int, int) const {}
    __device__ __forceinline__ void operator()(Acc& acc, const Unit& u, int wr, int wc, int fr, int fq) const {
        const int pn = u.pn, seg = pn >> 1;
        const int row0 = u.pm * BM + wr * 64 + fr;
        bf16_t* base = pn < 8 ? QK : G; const int colt = (pn < 8 ? pn : pn - 8) * BM;
        const int col0 = colt + wc * 32 + 8 * fq;
        const float sc = (pn < 8 && (seg == 0 || seg == 2)) ? 0.125f : 1.0f;
        const bool do_rope = pn >= 4 && pn < 8 && (wc & 1) == 0;
        const bool do_sum = pn >= 6 && pn < 8;
        f32x4 cs_[2][2];
#pragma unroll
        for (int bj = 0; bj < 2; ++bj)
#pragma unroll
            for (int n = 0; n < 2; ++n) cs_[bj][n] = (f32x4){0.f, 0.f, 0.f, 0.f};
#pragma unroll
        for (int ai = 0; ai < 2; ++ai)
#pragma unroll
            for (int m = 0; m < 4; ++m) { const int row = row0 + ai * HALF + m * 16;
                if (do_rope) { const f32x4* cs = (const f32x4*)(rope + (size_t)(row & 8191) * 16);
                    const f32x4 c0 = cs[0], c1 = cs[1], c2 = cs[2], c3 = cs[3];
                    const f32x4 cosA = {c0[0], c0[2], c1[0], c1[2]}, cosB = {c2[0], c2[2], c3[0], c3[2]}, sinA = {c0[1], c0[3], c1[1], c1[3]}, sinB = {c2[1], c2[3], c3[1], c3[3]};
#pragma unroll
                    for (int bj = 0; bj < 2; ++bj)
#pragma unroll
                        for (int n = 0; n < 2; ++n) { const f32x4 v = acc[ai][bj][m][n]; f32x4 p;
#pragma unroll
                            for (int i = 0; i < 4; ++i) p[i] = __shfl_xor(v[i], 16);
                            const f32x4 c = n == 0 ? cosA : cosB, sn = n == 0 ? sinA : sinB;
                            const f32x4 r = fq == 0 ? v * c - p * sn : v * c + p * sn;
                            if (fq < 2) acc[ai][bj][m][n] = r; } }
                bf16_t* rowp = base + (size_t)row * 2048 + col0;
#pragma unroll
                for (int bj = 0; bj < 2; ++bj) { cs_[bj][0] += acc[ai][bj][m][0]; cs_[bj][1] += acc[ai][bj][m][1];
                    const f32x4 v0 = acc[ai][bj][m][0] * sc, v1 = acc[ai][bj][m][1] * sc;
                    u32x4 w; w.x = cvt_pk_bf16(v0[0], v0[1]); w.y = cvt_pk_bf16(v0[2], v0[3]); w.z = cvt_pk_bf16(v1[0], v1[1]); w.w = cvt_pk_bf16(v1[2], v1[3]);
                    *(u32x4*)(rowp + bj * HALF) = w; }
                asm volatile("" ::: "memory"); }
        if (do_sum) {
#pragma unroll
            for (int bj = 0; bj < 2; ++bj)
#pragma unroll
                for (int n = 0; n < 2; ++n) { f32x4 s = cs_[bj][n];
#pragma unroll
                    for (int i = 0; i < 4; ++i) { float t = s[i]; t += __shfl_xor(t, 1); t += __shfl_xor(t, 2); t += __shfl_xor(t, 4); t += __shfl_xor(t, 8); s[i] = t; }
                    if (fr == 0) *(f32x4*)(kpart + ((size_t)u.pm * 2 + wr) * 512 + (pn - 6) * BM + bj * HALF + wc * 32 + 8 * fq + 4 * n) = s; }
        }
    }
};

struct EpiMerged {
    static constexpr bool PERM = true, MID = true;
    const bf16_t* G; bf16_t* O;
    __device__ __forceinline__ void mid(Acc& acc, const Unit& u, int wr, int wc, int fr_, int fq) const {
        int fr = fr_; asm volatile("" : "+v"(fr));
        const int row0 = u.pm * BM + wr * 64 + fr, col0 = u.pn * BM + wc * 32 + 8 * fq;
#pragma unroll
        for (int ai = 0; ai < 2; ++ai)
#pragma unroll
            for (int m = 0; m < 4; ++m) { const bf16_t* gp = G + (size_t)(row0 + ai * HALF + m * 16) * 2048 + col0;
#pragma unroll
                for (int bj = 0; bj < 2; ++bj) { const u32x4 a = *(const u32x4*)(gp + bj * HALF), b = *(const u32x4*)(gp + 1024 + bj * HALF);
#pragma unroll
                    for (int j = 0; j < 4; ++j) { const float a0 = bf_lo(a[j]), a1 = bf_hi(a[j]), b0 = fmaxf(bf_lo(b[j]), -60.f), b1 = fmaxf(bf_hi(b[j]), -60.f);
                        const float r0 = sigmoidf_(a0) * (1.0f + __expf(-b0)), r1 = sigmoidf_(a1) * (1.0f + __expf(-b1));
                        acc[ai][bj][m][j >> 1][(j & 1) * 2] *= r0; acc[ai][bj][m][j >> 1][(j & 1) * 2 + 1] *= r1; } }
                asm volatile("" ::: "memory"); }
    }
    __device__ __forceinline__ void operator()(Acc& acc, const Unit& u, int wr, int wc, int fr, int fq) const {
        const int row0 = u.pm * BM + wr * 64 + fr, col0 = u.pn * BM + wc * 32 + 8 * fq;
#pragma unroll
        for (int ai = 0; ai < 2; ++ai)
#pragma unroll
            for (int m = 0; m < 4; ++m) { const size_t r = (size_t)(row0 + ai * HALF + m * 16);
#pragma unroll
                for (int bj = 0; bj < 2; ++bj) { const u32x4 b = *(const u32x4*)(G + r * 2048 + 1024 + col0 + bj * HALF);
                    float o[8];
#pragma unroll
                    for (int j = 0; j < 4; ++j) { const float b0 = fmaxf(bf_lo(b[j]), -60.f), b1 = fmaxf(bf_hi(b[j]), -60.f);
                        o[2 * j] = acc[ai][bj][m][j >> 1][(j & 1) * 2] * sigmoidf_(b0); o[2 * j + 1] = acc[ai][bj][m][j >> 1][(j & 1) * 2 + 1] * sigmoidf_(b1); }
                    u32x4 w; w.x = cvt_pk_bf16(o[0], o[1]); w.y = cvt_pk_bf16(o[2], o[3]); w.z = cvt_pk_bf16(o[4], o[5]); w.w = cvt_pk_bf16(o[6], o[7]);
                    *(u32x4*)(O + r * 1024 + col0 + bj * HALF) = w; }
                asm volatile("" ::: "memory"); }
    }
};

struct EpiResid {
    static constexpr bool PERM = false, MID = false;
    const float* X; float* Y; float alpha;
    __device__ __forceinline__ void mid(Acc&, const Unit&, int, int, int, int) const {}
    __device__ __forceinline__ void operator()(Acc& acc, const Unit& u, int wr, int wc, int fr, int fq) const {
        const int row0 = u.pm * BM + wr * 64 + fr, col0 = u.pn * BM + wc * 32 + 4 * fq;
#pragma unroll
        for (int ai = 0; ai < 2; ++ai)
#pragma unroll
            for (int m = 0; m < 4; ++m) { const size_t off = (size_t)(row0 + ai * HALF + m * 16) * 1024 + col0;
#pragma unroll
                for (int bj = 0; bj < 2; ++bj)
#pragma unroll
                    for (int n = 0; n < 2; ++n) { const f32x4 x = *(const f32x4*)(X + off + bj * HALF + n * 16);
                        *(f32x4*)(Y + off + bj * HALF + n * 16) = x * alpha + acc[ai][bj][m][n]; } }
    }
};

struct EpiSwiglu {
    static constexpr bool PERM = true, MID = false;
    bf16_t* H;
    __device__ __forceinline__ void mid(Acc&, const Unit&, int, int, int, int) const {}
    __device__ __forceinline__ void operator()(Acc& acc, const Unit& u, int wr, int wc, int fr, int fq) const {
        const int row0 = u.pm * BM + wr * 64 + fr, col0 = u.pn * HALF + wc * 32 + 8 * fq;
#pragma unroll
        for (int ai = 0; ai < 2; ++ai)
#pragma unroll
            for (int m = 0; m < 4; ++m) { float o[8];
#pragma unroll
                for (int n = 0; n < 2; ++n)
#pragma unroll
                    for (int i = 0; i < 4; ++i) { const float g = acc[ai][0][m][n][i], up = acc[ai][1][m][n][i]; o[4 * n + i] = g * sigmoidf_(g) * up; }
                u32x4 w; w.x = cvt_pk_bf16(o[0], o[1]); w.y = cvt_pk_bf16(o[2], o[3]); w.z = cvt_pk_bf16(o[4], o[5]); w.w = cvt_pk_bf16(o[6], o[7]);
                *(u32x4*)(H + (size_t)(row0 + ai * HALF + m * 16) * 2816 + col0) = w; }
    }
};

template <class Epi, bool ALIGN_EPI>
__device__ __forceinline__ void gemm_phase(PG8_LAS unsigned char* lds, const Gemm g, const StaticOrder& S, const Epi& E) {
    int tid_ = threadIdx.x; asm volatile("" : "+v"(tid_));
    const int tid = tid_, wid = __builtin_amdgcn_readfirstlane(tid >> 6), lane = tid & 63, wr = wid >> 2, wc = wid & 3, fr = lane & 15, fq = lane >> 4;
    const int K = g.K, nt = K / BK;
    unsigned voffA[2], voffB[2];
#pragma unroll
    for (int i = 0; i < 2; ++i) { int R, C; stage_rc(tid * 16 + i * 8192, R, C); const int Rb = Epi::PERM ? ((R & ~31) + perm32(R & 31)) : R;
        voffA[i] = (unsigned)(R * K + C) * 2u; voffB[i] = (unsigned)(Rb * K + C) * 2u; }
    const size_t kstep = (size_t)(BK * 2);
    const size_t hstep = (size_t)HALF * K * 2;
    const size_t tstep = 2 * hstep;
    const unsigned ldsw = (unsigned)wid * 1024u;
    const int aoff = lds_byte(wr * 64 + fr, fq * 8), boff = lds_byte(wc * 32 + fr, fq * 8);
#define PG8_SA(b, h) (((b) * 2 + (h)) * HTB)
#define PG8_SB(b, h) ((4 + (b) * 2 + (h)) * HTB)
#define PG8_STAGE(bufoff, gbase, voff) do { _Pragma("unroll") for (int _i = 0; _i < 2; ++_i) \
        __builtin_amdgcn_global_load_lds((const unsigned*)((const char*)(gbase) + (voff)[_i]), (PG8_LAS unsigned*)(lds + (bufoff) + ldsw + _i * 8192), 16, 0, 0); } while (0)
#define PG8_LDA(dst, b, h) do { _Pragma("unroll") for (int m = 0; m < 4; ++m) _Pragma("unroll") for (int k = 0; k < 2; ++k) dst[m][k] = *(const PG8_LAS bf16x8*)(lds + PG8_SA(b, h) + aoff + m * 2048 + k * 1024); } while (0)
#define PG8_LDB(dst, b, h) do { _Pragma("unroll") for (int n = 0; n < 2; ++n) _Pragma("unroll") for (int k = 0; k < 2; ++k) dst[n][k] = *(const PG8_LAS bf16x8*)(lds + PG8_SB(b, h) + boff + n * 2048 + k * 1024); } while (0)
#define PG8_MMA(ai, bj, At, Bt) do { __builtin_amdgcn_s_setprio(1); _Pragma("unroll") for (int m = 0; m < 4; ++m) _Pragma("unroll") for (int n = 0; n < 2; ++n) _Pragma("unroll") for (int k = 0; k < 2; ++k) \
        acc[ai][bj][m][n] = __builtin_amdgcn_mfma_f32_16x16x32_bf16(Bt[n][k], At[m][k], acc[ai][bj][m][n], 0, 0, 0); __builtin_amdgcn_s_setprio(0); } while (0)
#define PG8_WAIT_V(n) asm volatile("s_waitcnt vmcnt(" #n ")" ::: "memory")
#define PG8_WAIT_L(n) asm volatile("s_waitcnt lgkmcnt(" #n ")" ::: "memory")
#define PG8_BAR __builtin_amdgcn_s_barrier()
#define PG8_SCHED __builtin_amdgcn_sched_barrier(0)
    Unit cur, nxt; int ui = 0;
    if (!S.next(0, cur)) return;
    Acc acc;
#pragma unroll
    for (int a = 0; a < 2; ++a)
#pragma unroll
        for (int b = 0; b < 2; ++b)
#pragma unroll
            for (int m = 0; m < 4; ++m)
#pragma unroll
                for (int n = 0; n < 2; ++n) acc[a][b][m][n] = (f32x4){0.f, 0.f, 0.f, 0.f};
    bf16x8 At[4][2], B0[2][2], B1[2][2];
    const char* cA = (const char*)g.A + (size_t)cur.pm * tstep; const char* cB = (const char*)g.Bt + (size_t)cur.pn * tstep;
    PG8_STAGE(PG8_SB(0, 0), cB, voffB); PG8_STAGE(PG8_SB(0, 1), cB + hstep, voffB); PG8_STAGE(PG8_SA(0, 0), cA, voffA); PG8_STAGE(PG8_SA(0, 1), cA + hstep, voffA);
    if (wr == 1) PG8_BAR;
    PG8_WAIT_V(2); PG8_BAR;
    PG8_STAGE(PG8_SB(1, 0), cB + kstep, voffB); PG8_STAGE(PG8_SA(1, 0), cA + kstep, voffA); PG8_STAGE(PG8_SB(1, 1), cB + hstep + kstep, voffB);
    PG8_WAIT_V(6); PG8_BAR;
    for (;;) {
        const bool has_next = S.next(ui + 1, nxt);
        const char* nA = has_next ? (const char*)g.A + (size_t)nxt.pm * tstep : cA; const char* nB = has_next ? (const char*)g.Bt + (size_t)nxt.pn * tstep : cB;
        for (int t = 0; t < nt; t += 2) {
            if constexpr (Epi::MID) { if (t == nt / 2) E.mid(acc, cur, wr, wc, fr, fq); }
            const bool last = (t == nt - 2);
            const char* a1 = cA + (size_t)(t + 1) * kstep;
            const char* a2 = last ? nA : cA + (size_t)(t + 2) * kstep; const char* b2 = last ? nB : cB + (size_t)(t + 2) * kstep;
            const char* a3 = a2 + kstep; const char* b3 = b2 + kstep;
            PG8_LDB(B0, 0, 0); PG8_LDB(B1, 0, 1); PG8_SCHED; PG8_LDA(At, 0, 0); PG8_STAGE(PG8_SA(1, 1), a1 + hstep, voffA);
            PG8_WAIT_V(8); PG8_WAIT_L(0); PG8_BAR; PG8_MMA(0, 0, At, B0); PG8_MMA(0, 1, At, B1); PG8_BAR; PG8_SCHED;
            PG8_LDA(At, 0, 1); PG8_STAGE(PG8_SB(0, 0), b2, voffB); PG8_STAGE(PG8_SB(0, 1), b2 + hstep, voffB); PG8_STAGE(PG8_SA(0, 0), a2, voffA);
            PG8_WAIT_V(8); PG8_WAIT_L(0); PG8_BAR; PG8_MMA(1, 0, At, B0); PG8_MMA(1, 1, At, B1); PG8_BAR; PG8_SCHED;
            PG8_LDB(B0, 1, 0); PG8_LDB(B1, 1, 1); PG8_SCHED; PG8_LDA(At, 1, 0); PG8_STAGE(PG8_SA(0, 1), a2 + hstep, voffA);
            PG8_WAIT_V(8); PG8_WAIT_L(0); PG8_BAR; PG8_MMA(0, 0, At, B0); PG8_MMA(0, 1, At, B1); PG8_BAR; PG8_SCHED;
            PG8_LDA(At, 1, 1); PG8_STAGE(PG8_SB(1, 0), b3, voffB); PG8_STAGE(PG8_SB(1, 1), b3 + hstep, voffB); PG8_STAGE(PG8_SA(1, 0), a3, voffA);
            PG8_WAIT_V(8); PG8_WAIT_L(0); PG8_BAR; PG8_MMA(1, 0, At, B0); PG8_MMA(1, 1, At, B1); PG8_BAR; PG8_SCHED;
        }
        if constexpr (ALIGN_EPI) { if (wr == 0) PG8_BAR; }
        E(acc, cur, wr, wc, fr, fq);
        if (!has_next) break;
#pragma unroll
        for (int a = 0; a < 2; ++a)
#pragma unroll
            for (int b = 0; b < 2; ++b)
#pragma unroll
                for (int m = 0; m < 4; ++m)
#pragma unroll
                    for (int n = 0; n < 2; ++n) acc[a][b][m][n] = (f32x4){0.f, 0.f, 0.f, 0.f};
        cur = nxt; cA = nA; cB = nB; ++ui;
        if constexpr (ALIGN_EPI) { if (wr == 1) PG8_BAR; }
    }
    PG8_WAIT_V(0);
    if constexpr (!ALIGN_EPI) { if (wr == 0) PG8_BAR; }
    PG8_BAR;
#undef PG8_SA
#undef PG8_SB
#undef PG8_STAGE
#undef PG8_LDA
#undef PG8_LDB
#undef PG8_MMA
#undef PG8_WAIT_V
#undef PG8_WAIT_L
#undef PG8_BAR
#undef PG8_SCHED
}
}

constexpr int NWAVES = 8, NTHREADS = 512;
constexpr int BATCH = 2, SEQ = 8192, D = 1024, M = BATCH * SEQ, DFF = 2816, DEPTH = 2, HD = 64, NH = 8;
constexpr int IN_COLS = 5120;
constexpr float LN_EPS = 1e-5f;
constexpr float ALPHA = 1.41421356237309515f;

typedef unsigned short bf16;
typedef unsigned v4u __attribute__((ext_vector_type(4)));
typedef float f32x4 __attribute__((ext_vector_type(4)));
#define LAS __attribute__((address_space(3)))

constexpr size_t MiB = 1u << 20;
constexpr size_t WS_W = 0, W_LAYER = 31 * MiB;
constexpr size_t WO_MAIN = 0;
constexpr size_t WO_VT = WO_MAIN + (size_t)4096 * 1024 * 2;
constexpr size_t WO_BR = WO_VT + (size_t)1024 * 1024 * 2;
constexpr size_t WO_OUT = WO_BR + (size_t)1024 * 1024 * 2;
constexpr size_t WO_GU = WO_OUT + (size_t)1024 * 1024 * 2;
constexpr size_t WO_DN = WO_GU + (size_t)5632 * 1024 * 2;
static_assert(WO_DN + (size_t)1024 * 2816 * 2 <= W_LAYER, "weights per layer");
constexpr size_t WS_XN = 62 * MiB;
constexpr size_t WS_O = WS_XN;
constexpr size_t WS_QK = 94 * MiB;
constexpr size_t WS_MG = WS_QK, WS_H = WS_QK;
constexpr size_t WS_G = 158 * MiB;
constexpr size_t WS_Y = WS_G;
constexpr size_t WS_Y2 = 182 * MiB;
constexpr size_t WS_VT = 222 * MiB;
constexpr size_t WS_ROPE = 254 * MiB;
constexpr size_t WS_KPART = WS_ROPE + 512 * 1024;
constexpr size_t WS_END = 256 * MiB;
static_assert(WS_H + (size_t)M * DFF * 2 <= WS_Y2 && WS_Y2 + (size_t)M * D * 4 <= WS_ROPE && WS_KPART + 64 * 2 * 512 * 4 <= WS_END, "d_ws map");

constexpr int RING_BYTES = 131072, LDS_BYTES = 147456;

__device__ __forceinline__ unsigned f2bf(float f) { unsigned u = __builtin_bit_cast(unsigned, f); return (u + 0x7fffu + ((u >> 16) & 1u)) >> 16; }
__device__ __forceinline__ unsigned pk2(float lo, float hi) { return f2bf(lo) | (f2bf(hi) << 16); }
__device__ __forceinline__ float bflo(unsigned w) { return __uint_as_float(w << 16); }
__device__ __forceinline__ float bfhi(unsigned w) { return __uint_as_float(w & 0xffff0000u); }
__device__ __forceinline__ float wave_sum(float v) {
#pragma unroll
    for (int o = 1; o < 64; o <<= 1) v += __shfl_xor(v, o);
    return v;
}

__device__ __forceinline__ void transpose_item(const float* W, int N, int kb, int nb, bf16* dst, int row0, int ld, int col_off, LAS float* scr, int lane) {
    const int k0 = 64 * kb, n0 = 32 * nb;
#pragma unroll 8
    for (int i = 0; i < 32; ++i) { const int kk = 2 * i + (lane >> 5); scr[kk * 33 + (lane & 31)] = W[(size_t)(k0 + kk) * N + n0 + (lane & 31)]; }
    asm volatile("s_waitcnt lgkmcnt(0)" ::: "memory");
    const int c = lane & 7;
#pragma unroll
    for (int j = 0; j < 4; ++j) { const int n = (lane >> 3) + 8 * j; const LAS float* s = scr + (8 * c) * 33 + n;
        v4u o; o.x = pk2(s[0 * 33], s[1 * 33]); o.y = pk2(s[2 * 33], s[3 * 33]); o.z = pk2(s[4 * 33], s[5 * 33]); o.w = pk2(s[6 * 33], s[7 * 33]);
        *(v4u*)(dst + (size_t)(row0 + n) * ld + col_off + k0 + 8 * c) = o; }
    asm volatile("s_waitcnt lgkmcnt(0)" ::: "memory");
}

struct Args { const float* in[12]; float* out; unsigned char* ws; };

__device__ __forceinline__ void prologue(const Args& a, LAS unsigned char* lds, int gw, int NGW, int wave, int lane) {
    LAS float* scr = (LAS float*)(lds + wave * 16384);
    constexpr int I_IN = 16 * 160, I_BR = 8 * 32, I_OUT = 16 * 32, I_G = 16 * 88, I_DN = 44 * 32;
    constexpr int PER_LAYER = I_IN + 2 * I_BR + I_OUT + 2 * I_G + I_DN;
    for (int it = gw; it < DEPTH * PER_LAYER; it += NGW) {
        const int l = it / PER_LAYER; int r = it % PER_LAYER;
        unsigned char* wl = a.ws + WS_W + (size_t)l * W_LAYER;
        if (r < I_IN) { const int kb = r / 160, nb = r % 160, c = nb * 32;
            bf16* dst; int row0;
            if (c < 1024) { dst = (bf16*)(wl + WO_MAIN); row0 = c; }
            else if (c < 1536) { dst = (bf16*)(wl + WO_VT); row0 = c - 1024; }
            else if (c < 2560) { dst = (bf16*)(wl + WO_MAIN); row0 = c - 1536 + 1024; }
            else if (c < 3072) { dst = (bf16*)(wl + WO_VT); row0 = c - 2560 + 512; }
            else { dst = (bf16*)(wl + WO_MAIN); row0 = c - 3072 + 2048; }
            transpose_item(a.in[1] + (size_t)l * 1024 * IN_COLS, IN_COLS, kb, nb, dst, row0, 1024, 0, scr, lane); continue; }
        r -= I_IN;
        if (r < I_BR) { transpose_item(a.in[2] + (size_t)l * 512 * 1024, 1024, r / 32, r % 32, (bf16*)(wl + WO_BR), (r % 32) * 32, 1024, 0, scr, lane); continue; }
        r -= I_BR;
        if (r < I_BR) { transpose_item(a.in[3] + (size_t)l * 512 * 1024, 1024, r / 32, r % 32, (bf16*)(wl + WO_BR), (r % 32) * 32, 1024, 512, scr, lane); continue; }
        r -= I_BR;
        if (r < I_OUT) { transpose_item(a.in[4] + (size_t)l * 1024 * 1024, 1024, r / 32, r % 32, (bf16*)(wl + WO_OUT), (r % 32) * 32, 1024, 0, scr, lane); continue; }
        r -= I_OUT;
        if (r < I_G) { const int nb = r % 88, c = nb * 32; transpose_item(a.in[7] + (size_t)l * 1024 * DFF, DFF, r / 88, nb, (bf16*)(wl + WO_GU), 256 * (c / 128) + (c % 128), 1024, 0, scr, lane); continue; }
        r -= I_G;
        if (r < I_G) { const int nb = r % 88, c = nb * 32; transpose_item(a.in[8] + (size_t)l * 1024 * DFF, DFF, r / 88, nb, (bf16*)(wl + WO_GU), 256 * (c / 128) + 128 + (c % 128), 1024, 0, scr, lane); continue; }
        r -= I_G;
        transpose_item(a.in[9] + (size_t)l * DFF * 1024, 1024, r / 32, r % 32, (bf16*)(wl + WO_DN), (r % 32) * 32, DFF, 0, scr, lane);
    }
    bf16* XN = (bf16*)(a.ws + WS_XN);
    for (int m = gw; m < M; m += NGW) { const f32x4* xr = (const f32x4*)(a.in[0] + (size_t)m * D) + lane; unsigned long long* o8 = (unsigned long long*)(XN + (size_t)m * D) + lane;
#pragma unroll
        for (int j = 0; j < 4; ++j) { const f32x4 v = xr[64 * j]; o8[64 * j] = (unsigned long long)pk2(v.x, v.y) | ((unsigned long long)pk2(v.z, v.w) << 32); } }
    float* rope = (float*)(a.ws + WS_ROPE);
    for (int e = gw * 64 + lane; e < SEQ * 8; e += NGW * 64) { const int pos = e >> 3, i = e & 7;
        const double ang = (double)pos * exp(-(double)i * 0.125 * log(500000.0));
        rope[2 * e] = (float)cos(ang); rope[2 * e + 1] = (float)sin(ang); }
}

__device__ __forceinline__ void ln_phase(const float* Y, const float* gam, const float* bet, float* X, bf16* XN, int gw, int NGW, int lane_) {
    int lane = lane_; asm volatile("" : "+v"(lane));
    for (int m = gw; m < M; m += NGW) {
        const f32x4* yr = (const f32x4*)(Y + (size_t)m * D) + lane;
        f32x4 v[4]; float s = 0.f;
#pragma unroll
        for (int j = 0; j < 4; ++j) { v[j] = yr[64 * j]; s += (v[j].x + v[j].y) + (v[j].z + v[j].w); }
        const float mean = wave_sum(s) * (1.f / D); float s2 = 0.f;
#pragma unroll
        for (int j = 0; j < 4; ++j) { v[j] = v[j] - mean; s2 += (v[j].x * v[j].x + v[j].y * v[j].y) + (v[j].z * v[j].z + v[j].w * v[j].w); }
        const float rstd = 1.f / sqrtf(wave_sum(s2) * (1.f / D) + LN_EPS);
        f32x4* xo = (f32x4*)(X + (size_t)m * D) + lane; unsigned long long* o8 = (unsigned long long*)(XN + (size_t)m * D) + lane;
#pragma unroll
        for (int j = 0; j < 4; ++j) { const f32x4 g = ((const f32x4*)gam)[lane + 64 * j], b = ((const f32x4*)bet)[lane + 64 * j];
            const f32x4 o = v[j] * rstd * g + b; xo[64 * j] = o;
            o8[64 * j] = (unsigned long long)pk2(o.x, o.y) | ((unsigned long long)pk2(o.z, o.w) << 32); }
    }
}

__device__ __forceinline__ float dot8(v4u q, v4u k) {
    return bflo(q.x) * bflo(k.x) + bfhi(q.x) * bfhi(k.x) + bflo(q.y) * bflo(k.y) + bfhi(q.y) * bfhi(k.y) + bflo(q.z) * bflo(k.z) + bfhi(q.z) * bfhi(k.z) + bflo(q.w) * bflo(k.w) + bfhi(q.w) * bfhi(k.w);
}
__device__ __forceinline__ float quad_sum(float v) { v += __shfl_xor(v, 1); v += __shfl_xor(v, 2); return v; }
__device__ __forceinline__ void dots8(float* z, v4u q0, v4u q1, const bf16* krow0_) {
    const bf16* krow0 = krow0_; asm volatile("" : "+v"(krow0));
#pragma unroll
    for (int i = 0; i < 8; ++i) { const bf16* kr = krow0 + (size_t)i * 2048;
        z[i] = quad_sum(dot8(q0, *(const v4u*)kr) + dot8(q1, *(const v4u*)(kr + 8))); }
}
__device__ __forceinline__ void accum_v8(float* o, const float* w, const bf16* vcol0_) {
    const bf16* vcol0 = vcol0_; asm volatile("" : "+v"(vcol0));
#pragma unroll
    for (int d = 0; d < 16; ++d) { const v4u v = *(const v4u*)(vcol0 + (size_t)d * M);
        o[d] += w[0] * bflo(v.x) + w[1] * bfhi(v.x) + w[2] * bflo(v.y) + w[3] * bfhi(v.y) + w[4] * bflo(v.z) + w[5] * bfhi(v.z) + w[6] * bflo(v.w) + w[7] * bfhi(v.w); }
}
__device__ __forceinline__ void store_o16(const float* o, float sc, bf16* p) {
#pragma unroll
    for (int c = 0; c < 2; ++c) { v4u w; w.x = pk2(o[8 * c] * sc, o[8 * c + 1] * sc); w.y = pk2(o[8 * c + 2] * sc, o[8 * c + 3] * sc); w.z = pk2(o[8 * c + 4] * sc, o[8 * c + 5] * sc); w.w = pk2(o[8 * c + 6] * sc, o[8 * c + 7] * sc);
        *(v4u*)(p + 8 * c) = w; }
}

__device__ __forceinline__ void sb_thread(const bf16* QK, const bf16* Vt, bf16* O, int b, int h, int q, int part) {
    const size_t row = (size_t)b * SEQ + q;
    const bf16* qp = QK + row * 2048 + h * 64 + part * 16;
    const v4u q0 = *(const v4u*)qp, q1 = *(const v4u*)(qp + 8);
    float o[16];
#pragma unroll
    for (int d = 0; d < 16; ++d) o[d] = 0.f;
    float c = 0.f;
    const bf16* Kb = QK + (size_t)b * SEQ * 2048 + 512 + h * 64 + part * 16;
    const bf16* Vb = Vt + (size_t)(h * 64 + part * 16) * M + (size_t)b * SEQ;
    for (int s0 = (q - 1) & ~7; s0 >= 0 && q > 0; s0 -= 8) {
        float z[8], w[8]; dots8(z, q0, q1, Kb + (size_t)s0 * 2048);
#pragma unroll
        for (int i = 7; i >= 0; --i) {
            const float zz = z[i]; const float l1p = __logf(1.0f + __expf(-fabsf(zz)));
            const float lk = -(fmaxf(zz, 0.f) + l1p), ls = fminf(zz, 0.f) - l1p;
            const bool past = (s0 + i) < q;
            w[i] = past ? __expf(ls + c) : 0.f; c += past ? lk : 0.f; }
        accum_v8(o, w, Vb + s0);
        if (c < -88.0f) break;
    }
    store_o16(o, 1.0f, O + row * 1024 + h * 64 + part * 16);
}

__device__ __forceinline__ void moba_chunk(float* o, float& mrun, float& lrun, v4u q0, v4u q1, const bf16* Kb, const bf16* Vb, int s0, int q) {
    float z[8]; dots8(z, q0, q1, Kb + (size_t)s0 * 2048);
    float mx = -INFINITY;
#pragma unroll
    for (int i = 0; i < 8; ++i) { if (s0 + i > q) z[i] = -INFINITY; mx = fmaxf(mx, z[i]); }
    const float mnew = fmaxf(mrun, mx), al = __expf(mrun - mnew);
    float w[8], ps = 0.f;
#pragma unroll
    for (int i = 0; i < 8; ++i) { w[i] = __expf(z[i] - mnew); ps += w[i]; }
    lrun = lrun * al + ps; mrun = mnew;
#pragma unroll
    for (int d = 0; d < 16; ++d) o[d] *= al;
    accum_v8(o, w, Vb + s0);
}

__device__ __forceinline__ void moba_thread(const bf16* QK, const bf16* Vt, bf16* O, const LAS float* kmean, int b, int h, int q, int part) {
    const size_t row = (size_t)b * SEQ + q;
    const bf16* qp = QK + row * 2048 + 1024 + h * 64 + part * 16;
    const v4u q0 = *(const v4u*)qp, q1 = *(const v4u*)(qp + 8);
    const int own = q >> 8;
    float v1 = -INFINITY, v2 = -INFINITY, v3 = -INFINITY; int i1 = 0, i2 = 0, i3 = 0;
    for (int j = 0; j < own; ++j) { const LAS float* k8 = kmean + j * 64 + part * 16;
        float g = bflo(q0.x) * k8[0] + bfhi(q0.x) * k8[1] + bflo(q0.y) * k8[2] + bfhi(q0.y) * k8[3] + bflo(q0.z) * k8[4] + bfhi(q0.z) * k8[5] + bflo(q0.w) * k8[6] + bfhi(q0.w) * k8[7]
                + bflo(q1.x) * k8[8] + bfhi(q1.x) * k8[9] + bflo(q1.y) * k8[10] + bfhi(q1.y) * k8[11] + bflo(q1.z) * k8[12] + bfhi(q1.z) * k8[13] + bflo(q1.w) * k8[14] + bfhi(q1.w) * k8[15];
        g = quad_sum(g);
        if (g > v1) { v3 = v2; i3 = i2; v2 = v1; i2 = i1; v1 = g; i1 = j; }
        else if (g > v2) { v3 = v2; i3 = i2; v2 = g; i2 = j; }
        else if (g > v3) { v3 = g; i3 = j; } }
    const int nsel = own < 3 ? own : 3;
    float o[16];
#pragma unroll
    for (int d = 0; d < 16; ++d) o[d] = 0.f;
    float mrun = -INFINITY, lrun = 0.f;
    const bf16* Kb = QK + (size_t)b * SEQ * 2048 + 1536 + h * 64 + part * 16;
    const bf16* Vb = Vt + (size_t)(512 + h * 64 + part * 16) * M + (size_t)b * SEQ;
    for (int t = 0; t < nsel; ++t) { const int blk = t == 0 ? i1 : (t == 1 ? i2 : i3);
        for (int s0 = blk * 256; s0 < blk * 256 + 256; s0 += 8) moba_chunk(o, mrun, lrun, q0, q1, Kb, Vb, s0, q); }
    for (int s0 = own * 256; s0 <= q; s0 += 8) moba_chunk(o, mrun, lrun, q0, q1, Kb, Vb, s0, q);
    store_o16(o, 1.0f / lrun, O + row * 1024 + 512 + h * 64 + part * 16);
}

typedef short bf16x8_t __attribute__((ext_vector_type(8)));
typedef float f32x16 __attribute__((ext_vector_type(16)));
__device__ __forceinline__ unsigned cvtpk(float lo, float hi) { unsigned r; asm volatile("v_cvt_pk_bf16_f32 %0, %1, %2" : "=v"(r) : "v"(lo), "v"(hi)); return r; }
__device__ __forceinline__ bf16x8_t pack8(const float* w) { v4u p; p.x = cvtpk(w[0], w[1]); p.y = cvtpk(w[2], w[3]); p.z = cvtpk(w[4], w[5]); p.w = cvtpk(w[6], w[7]); return __builtin_bit_cast(bf16x8_t, p); }
constexpr float SB_STOP = -88.0f;

__device__ __forceinline__ void sb_wave(const bf16* QK, const bf16* Vt, bf16* O, int b, int h, int qt, int lane) {
    const int n = lane & 31, hi = lane >> 5;
    const size_t rowq = (size_t)b * SEQ + qt * 32 + n;
    bf16x8_t qf[4];
#pragma unroll
    for (int d0 = 0; d0 < 4; ++d0) qf[d0] = *(const bf16x8_t*)(QK + rowq * 2048 + h * 64 + 16 * d0 + 8 * hi);
    const int pr = (n & ~12) | ((n & 4) << 1) | ((n & 8) >> 1);
    const bf16* Kb = QK + ((size_t)b * SEQ + pr) * 2048 + 512 + h * 64 + 8 * hi;
    const bf16* Vb = Vt + (size_t)(h * 64 + n) * M + (size_t)b * SEQ + 8 * hi;
    f32x16 o0 = {}, o1 = {};
    float c = 0.f;
    for (int kt = qt; kt >= 0; --kt) {
        const bf16* kp = Kb + (size_t)kt * 32 * 2048;
        bf16x8_t kf[4];
#pragma unroll
        for (int d0 = 0; d0 < 4; ++d0) kf[d0] = *(const bf16x8_t*)(kp + 16 * d0);
        const bf16* vp = Vb + kt * 32;
        const bf16x8_t v00 = *(const bf16x8_t*)(vp), v01 = *(const bf16x8_t*)(vp + 16), v10 = *(const bf16x8_t*)(vp + (size_t)32 * M), v11 = *(const bf16x8_t*)(vp + (size_t)32 * M + 16);
        f32x16 s = {};
#pragma unroll
        for (int d0 = 0; d0 < 4; ++d0) s = __builtin_amdgcn_mfma_f32_32x32x16_bf16(kf[d0], qf[d0], s, 0, 0, 0);
        float lk[16], ls[16];
        const bool diag = (kt == qt);
#pragma unroll
        for (int r = 0; r < 16; ++r) { const float zz = s[r]; const float l1p = __logf(1.0f + __expf(-fabsf(zz)));
            const bool past = !diag || (16 * (r >> 3) + 8 * hi + (r & 7)) < n;
            lk[r] = past ? -(fmaxf(zz, 0.f) + l1p) : 0.f; ls[r] = past ? fminf(zz, 0.f) - l1p : -INFINITY; }
        const float G0 = ((lk[0] + lk[1]) + (lk[2] + lk[3])) + ((lk[4] + lk[5]) + (lk[6] + lk[7])), G1 = ((lk[8] + lk[9]) + (lk[10] + lk[11])) + ((lk[12] + lk[13]) + (lk[14] + lk[15]));
        const float oG0 = __shfl_xor(G0, 32), oG1 = __shfl_xor(G1, 32);
        const float tailA = c + (hi == 0 ? (oG0 + G1) + oG1 : G1 + oG1), tailB = c + (hi == 0 ? oG1 : 0.f);
        float w[16]; float run = 0.f;
#pragma unroll
        for (int r = 7; r >= 0; --r) { w[r] = __expf(ls[r] + (run + tailA)); run += lk[r]; }
        run = 0.f;
#pragma unroll
        for (int r = 15; r >= 8; --r) { w[r] = __expf(ls[r] + (run + tailB)); run += lk[r]; }
        c += (G0 + oG0) + (G1 + oG1);
        const bf16x8_t pa0 = pack8(w), pa1 = pack8(w + 8);
        o0 = __builtin_amdgcn_mfma_f32_32x32x16_bf16(v00, pa0, o0, 0, 0, 0); o0 = __builtin_amdgcn_mfma_f32_32x32x16_bf16(v01, pa1, o0, 0, 0, 0);
        o1 = __builtin_amdgcn_mfma_f32_32x32x16_bf16(v10, pa0, o1, 0, 0, 0); o1 = __builtin_amdgcn_mfma_f32_32x32x16_bf16(v11, pa1, o1, 0, 0, 0);
        if (__all(c < SB_STOP)) break;
    }
    bf16* op = O + rowq * 1024 + h * 64 + 4 * hi;
#pragma unroll
    for (int g4 = 0; g4 < 4; ++g4) {
        unsigned long long a = (unsigned long long)cvtpk(o0[4 * g4], o0[4 * g4 + 1]) | ((unsigned long long)cvtpk(o0[4 * g4 + 2], o0[4 * g4 + 3]) << 32);
        unsigned long long c1 = (unsigned long long)cvtpk(o1[4 * g4], o1[4 * g4 + 1]) | ((unsigned long long)cvtpk(o1[4 * g4 + 2], o1[4 * g4 + 3]) << 32);
        *(unsigned long long*)(op + 8 * g4) = a; *(unsigned long long*)(op + 32 + 8 * g4) = c1; }
}

constexpr float LOG2E = 1.4426950408889634f;
constexpr int ML_KM = 0, ML_CNT = 8192, ML_CTR = ML_CNT + 128, ML_NGRP = ML_CTR + 4, ML_GRP = ML_CNT + 256, ML_LIST = ML_CNT + 1024, ML_PL = ML_LIST + 32 * 256 * 2, ML_PO = ML_PL + 256 * 4 * 4, ML_END = ML_PO + 256 * 3 * 64 * 2;
static_assert(ML_END <= 131072, "MoBA LDS map");
struct Flash { float m, l; f32x16 o0, o1; };
__device__ __forceinline__ void flash_tile(Flash& st, const bf16x8_t* qf, const bf16* kp, const bf16* vp, bool diag, int n, int hi) {
    bf16x8_t kf[4];
#pragma unroll
    for (int d0 = 0; d0 < 4; ++d0) kf[d0] = *(const bf16x8_t*)(kp + 16 * d0);
    const bf16x8_t v00 = *(const bf16x8_t*)(vp), v01 = *(const bf16x8_t*)(vp + 16), v10 = *(const bf16x8_t*)(vp + (size_t)32 * M), v11 = *(const bf16x8_t*)(vp + (size_t)32 * M + 16);
    f32x16 s = {};
#pragma unroll
    for (int d0 = 0; d0 < 4; ++d0) s = __builtin_amdgcn_mfma_f32_32x32x16_bf16(kf[d0], qf[d0], s, 0, 0, 0);
    float p[16]; float tmax = -INFINITY;
#pragma unroll
    for (int r = 0; r < 16; ++r) { float v = s[r] * LOG2E; if (diag && (16 * (r >> 3) + 8 * hi + (r & 7)) > n) v = -INFINITY; p[r] = v; tmax = fmaxf(tmax, v); }
    tmax = fmaxf(tmax, __shfl_xor(tmax, 32));
    const float mnew = fmaxf(st.m, tmax), alpha = __builtin_amdgcn_exp2f(st.m - mnew);
    float rs = 0.f;
#pragma unroll
    for (int r = 0; r < 16; ++r) { p[r] = __builtin_amdgcn_exp2f(p[r] - mnew); rs += p[r]; }
    rs += __shfl_xor(rs, 32);
    st.l = st.l * alpha + rs; st.m = mnew;
    st.o0 *= alpha; st.o1 *= alpha;
    const bf16x8_t pa0 = pack8(p), pa1 = pack8(p + 8);
    st.o0 = __builtin_amdgcn_mfma_f32_32x32x16_bf16(v00, pa0, st.o0, 0, 0, 0); st.o0 = __builtin_amdgcn_mfma_f32_32x32x16_bf16(v01, pa1, st.o0, 0, 0, 0);
    st.o1 = __builtin_amdgcn_mfma_f32_32x32x16_bf16(v10, pa0, st.o1, 0, 0, 0); st.o1 = __builtin_amdgcn_mfma_f32_32x32x16_bf16(v11, pa1, st.o1, 0, 0, 0);
}
__device__ __forceinline__ void split_bf16x8(const LAS float* src, bf16x8_t& hi8, bf16x8_t& lo8) {
    float x[8], lo[8];
#pragma unroll
    for (int i = 0; i < 8; ++i) x[i] = src[i];
    v4u h; h.x = cvtpk(x[0], x[1]); h.y = cvtpk(x[2], x[3]); h.z = cvtpk(x[4], x[5]); h.w = cvtpk(x[6], x[7]);
    lo[0] = x[0] - bflo(h.x); lo[1] = x[1] - bfhi(h.x); lo[2] = x[2] - bflo(h.y); lo[3] = x[3] - bfhi(h.y); lo[4] = x[4] - bflo(h.z); lo[5] = x[5] - bfhi(h.z); lo[6] = x[6] - bflo(h.w); lo[7] = x[7] - bfhi(h.w);
    hi8 = __builtin_bit_cast(bf16x8_t, h); lo8 = pack8(lo);
}

__device__ __forceinline__ void moba_unit(const bf16* QK, const bf16* Vt, bf16* O, const float* kpart, LAS unsigned char* lds, int b, int h, int qb, int tid) {
    const int lane = tid & 63, n = lane & 31, hi = lane >> 5, w = __builtin_amdgcn_readfirstlane(tid >> 6);
    LAS float* kmean = (LAS float*)(lds + ML_KM); LAS unsigned* cnt = (LAS unsigned*)(lds + ML_CNT); LAS unsigned* ctr = (LAS unsigned*)(lds + ML_CTR); LAS unsigned* ngrp = (LAS unsigned*)(lds + ML_NGRP);
    LAS unsigned* grp = (LAS unsigned*)(lds + ML_GRP); LAS unsigned short* list = (LAS unsigned short*)(lds + ML_LIST); LAS float* partL = (LAS float*)(lds + ML_PL); LAS bf16* partO = (LAS bf16*)(lds + ML_PO);
    __syncthreads();
    if (tid < 64) cnt[tid] = 0u;
    for (int e = tid; e < 32 * 64; e += NTHREADS) { const int j = e >> 6, d = e & 63; const float* kp = kpart + ((size_t)(b * 32 + j) * 2) * 512 + h * 64 + d;
        kmean[e] = (kp[0] + kp[512]) * (1.0f / 256.0f); }
    __syncthreads();
    const int pr = (n & ~12) | ((n & 4) << 1) | ((n & 8) >> 1);
    const bf16* Kb = QK + ((size_t)b * SEQ + pr) * 2048 + 1536 + h * 64 + 8 * hi;
    const bf16* Vb = Vt + (size_t)(512 + h * 64 + n) * M + (size_t)b * SEQ + 8 * hi;
    const bf16* Qb = QK + ((size_t)b * SEQ + qb * 256) * 2048 + 1024 + h * 64 + 8 * hi;
    const int qloc = w * 32 + n;
    bf16x8_t qf[4];
#pragma unroll
    for (int d0 = 0; d0 < 4; ++d0) qf[d0] = *(const bf16x8_t*)(Qb + (size_t)qloc * 2048 + 16 * d0);
    if (qb > 0) {
        f32x16 g = {};
#pragma unroll
        for (int d0 = 0; d0 < 4; ++d0) { bf16x8_t kh, kl; split_bf16x8(kmean + n * 64 + 16 * d0 + 8 * hi, kh, kl);
            g = __builtin_amdgcn_mfma_f32_32x32x16_bf16(kh, qf[d0], g, 0, 0, 0); g = __builtin_amdgcn_mfma_f32_32x32x16_bf16(kl, qf[d0], g, 0, 0, 0); }
        float gv[16];
#pragma unroll
        for (int r = 0; r < 16; ++r) { const int j = (r & 3) + 8 * (r >> 2) + 4 * hi; gv[r] = j < qb ? g[r] : -INFINITY; }
#pragma unroll
        for (int t = 0; t < 3; ++t) {
            float bv = -INFINITY; int bj = 64;
#pragma unroll
            for (int r = 0; r < 16; ++r) { const int j = (r & 3) + 8 * (r >> 2) + 4 * hi; if (gv[r] > bv) { bv = gv[r]; bj = j; } }
            const float pv = __shfl_xor(bv, 32); const int pj = __shfl_xor(bj, 32);
            if (pv > bv || (pv == bv && pj < bj)) { bv = pv; bj = pj; }
#pragma unroll
            for (int r = 0; r < 16; ++r) { const int j = (r & 3) + 8 * (r >> 2) + 4 * hi; if (j == bj) gv[r] = -INFINITY; }
            if (hi == 0 && bv > -INFINITY) { const unsigned pos = __hip_atomic_fetch_add(cnt + bj, 1u, __ATOMIC_RELAXED, __HIP_MEMORY_SCOPE_WORKGROUP);
                list[bj * 256 + pos] = (unsigned short)(qloc | (t << 8)); }
        }
    }
    __syncthreads();
    if (w == 0) { const unsigned c = n < qb ? cnt[n] : 0u; const int ng = hi == 0 ? (int)((c + 31u) >> 5) : 0;
        int incl = ng;
#pragma unroll
        for (int o = 1; o < 32; o <<= 1) { const int t = __shfl_up(incl, o); if (n >= o) incl += t; }
        const int base = incl - ng;
        if (hi == 0) { for (int k = 0; k < ng; ++k) grp[base + k] = (unsigned)n | ((unsigned)(k * 32) << 8); if (n == 31) ngrp[0] = (unsigned)incl; } }
    Flash own; own.m = -INFINITY; own.l = 0.f; own.o0 = (f32x16){}; own.o1 = (f32x16){};
    for (int kt = 0; kt <= w; ++kt) flash_tile(own, qf, Kb + (size_t)(qb * 256 + kt * 32) * 2048, Vb + qb * 256 + kt * 32, kt == w, n, hi);
    __syncthreads();
    const unsigned NG = ngrp[0];
    for (;;) {
        unsigned gi = 0; if (lane == 0) gi = __hip_atomic_fetch_add(ctr, 1u, __ATOMIC_RELAXED, __HIP_MEMORY_SCOPE_WORKGROUP);
        gi = __builtin_amdgcn_readfirstlane(gi);
        if (gi >= NG) break;
        const unsigned ge = grp[gi]; const int j = ge & 255, start = ge >> 8; const int cj = (int)cnt[j];
        const bool valid = start + n < cj;
        const unsigned e = list[j * 256 + (valid ? start + n : start)]; const int ql = e & 255, slot = e >> 8;
        bf16x8_t qg[4];
#pragma unroll
        for (int d0 = 0; d0 < 4; ++d0) qg[d0] = *(const bf16x8_t*)(Qb + (size_t)ql * 2048 + 16 * d0);
        Flash st; st.m = -INFINITY; st.l = 0.f; st.o0 = (f32x16){}; st.o1 = (f32x16){};
        for (int kt = 0; kt < 8; ++kt) flash_tile(st, qg, Kb + (size_t)(j * 256 + kt * 32) * 2048, Vb + j * 256 + kt * 32, false, n, hi);
        if (valid) { const float il = 1.0f / st.l; LAS bf16* po = partO + (ql * 3 + slot) * 64 + 4 * hi;
#pragma unroll
            for (int g4 = 0; g4 < 4; ++g4) {
                *(LAS unsigned long long*)(po + 8 * g4) = (unsigned long long)cvtpk(st.o0[4 * g4] * il, st.o0[4 * g4 + 1] * il) | ((unsigned long long)cvtpk(st.o0[4 * g4 + 2] * il, st.o0[4 * g4 + 3] * il) << 32);
                *(LAS unsigned long long*)(po + 32 + 8 * g4) = (unsigned long long)cvtpk(st.o1[4 * g4] * il, st.o1[4 * g4 + 1] * il) | ((unsigned long long)cvtpk(st.o1[4 * g4 + 2] * il, st.o1[4 * g4 + 3] * il) << 32); }
            if (hi == 0) partL[ql * 4 + slot] = st.m + __builtin_amdgcn_logf(st.l); }
    }
    __syncthreads();
    const int nsel = qb < 3 ? qb : 3;
    const float lse_o = own.m + __builtin_amdgcn_logf(own.l);
    float ls[3]; float mx = lse_o;
#pragma unroll
    for (int t = 0; t < 3; ++t) { ls[t] = t < nsel ? partL[qloc * 4 + t] : -INFINITY; mx = fmaxf(mx, ls[t]); }
    float wo = __builtin_amdgcn_exp2f(lse_o - mx), ws_[3], tot = wo;
#pragma unroll
    for (int t = 0; t < 3; ++t) { ws_[t] = __builtin_amdgcn_exp2f(ls[t] - mx); tot += ws_[t]; }
    const float it = 1.0f / tot; wo = wo * it / own.l;
    bf16* op = O + ((size_t)b * SEQ + qb * 256 + qloc) * 1024 + 512 + h * 64 + 4 * hi;
#pragma unroll
    for (int g4 = 0; g4 < 4; ++g4) {
        float a[4], c4[4];
#pragma unroll
        for (int i = 0; i < 4; ++i) { a[i] = own.o0[4 * g4 + i] * wo; c4[i] = own.o1[4 * g4 + i] * wo; }
#pragma unroll
        for (int t = 0; t < 3; ++t) if (t < nsel) { const float wt = ws_[t] * it; const LAS bf16* po = partO + (qloc * 3 + t) * 64 + 4 * hi;
            const unsigned long long u0 = *(const LAS unsigned long long*)(po + 8 * g4), u1 = *(const LAS unsigned long long*)(po + 32 + 8 * g4);
            a[0] += wt * bflo((unsigned)u0); a[1] += wt * bfhi((unsigned)u0); a[2] += wt * bflo((unsigned)(u0 >> 32)); a[3] += wt * bfhi((unsigned)(u0 >> 32));
            c4[0] += wt * bflo((unsigned)u1); c4[1] += wt * bfhi((unsigned)u1); c4[2] += wt * bflo((unsigned)(u1 >> 32)); c4[3] += wt * bfhi((unsigned)(u1 >> 32)); }
        *(unsigned long long*)(op + 8 * g4) = (unsigned long long)cvtpk(a[0], a[1]) | ((unsigned long long)cvtpk(a[2], a[3]) << 32);
        *(unsigned long long*)(op + 32 + 8 * g4) = (unsigned long long)cvtpk(c4[0], c4[1]) | ((unsigned long long)cvtpk(c4[2], c4[3]) << 32); }
}

__device__ __forceinline__ void attn_phase_v1(const Args& a, LAS unsigned char* lds, int G) {
    const bf16* QK = (const bf16*)(a.ws + WS_QK); const bf16* Vt = (const bf16*)(a.ws + WS_VT); bf16* O = (bf16*)(a.ws + WS_O);
    const float* kpart = (const float*)(a.ws + WS_KPART);
    for (int u = blockIdx.x; u < 256; u += G) {
        int tq = threadIdx.x; asm volatile("" : "+v"(tq));
        { const int bh = u >> 4, b = bh >> 3, h = bh & 7, wv = __builtin_amdgcn_readfirstlane(tq >> 6);
          for (int i = 0; i < 2; ++i) sb_wave(QK, Vt, O, b, h, (u & 15) * 16 + wv * 2 + i, tq & 63); }
        for (int k = 0; k < 2; ++k) { const int uu = k == 0 ? u : 511 - u, bh = uu >> 5, qb = uu & 31;
            moba_unit(QK, Vt, O, kpart, lds, bh >> 3, bh & 7, qb, tq); }
    }
}

__global__ void __launch_bounds__(NTHREADS, 2) fwd_megakernel(Args a) {
    extern __shared__ __attribute__((aligned(16))) unsigned char lds_raw[];
    LAS unsigned char* lds = (LAS unsigned char*)lds_raw;
    cg::grid_group grid = cg::this_grid();
    const int tid = threadIdx.x, lane = tid & 63, wave = __builtin_amdgcn_readfirstlane(tid >> 6);
    const int G = gridDim.x, gw = blockIdx.x * NWAVES + wave, NGW = G * NWAVES;
    unsigned char* ws = a.ws;
    bf16* XN = (bf16*)(ws + WS_XN); bf16* QK = (bf16*)(ws + WS_QK); bf16* Gt = (bf16*)(ws + WS_G); bf16* Vt = (bf16*)(ws + WS_VT); bf16* O = (bf16*)(ws + WS_O);
    bf16* MG = (bf16*)(ws + WS_MG); bf16* H = (bf16*)(ws + WS_H); float* Y = (float*)(ws + WS_Y); float* Y2 = (float*)(ws + WS_Y2);
    float* rope = (float*)(ws + WS_ROPE); float* kpart = (float*)(ws + WS_KPART);

    prologue(a, lds, gw, NGW, wave, lane);
    grid.sync();

    for (int l = 0; l < DEPTH; ++l) {
        const unsigned char* wl = ws + WS_W + (size_t)l * W_LAYER;
        const float* Xres = l == 0 ? a.in[0] : a.out;
        { pg8::Gemm g{XN, (const bf16*)(wl + WO_MAIN), M, 4096, 1024}; pg8::StaticOrder S; S.init(M, 4096, G, (int)blockIdx.x);
          pg8::EpiInProj E{QK, Gt, rope, kpart};
          pg8::gemm_phase<pg8::EpiInProj, true>(lds, g, S, E); }
        { pg8::Gemm g{(const bf16*)(wl + WO_VT), XN, 1024, M, 1024}; pg8::StaticOrder S; S.init(1024, M, G, (int)blockIdx.x);
          pg8::EpiBf16 E{Vt, M};
          pg8::gemm_phase<pg8::EpiBf16, true>(lds, g, S, E); }
        grid.sync();
        attn_phase_v1(a, lds, G);
        grid.sync();
        { pg8::Gemm g{O, (const bf16*)(wl + WO_BR), M, 1024, 1024}; pg8::StaticOrder S; S.init(M, 1024, G, (int)blockIdx.x);
          pg8::EpiMerged E{Gt, MG};
          pg8::gemm_phase<pg8::EpiMerged, false>(lds, g, S, E); }
        grid.sync();
        { pg8::Gemm g{MG, (const bf16*)(wl + WO_OUT), M, 1024, 1024}; pg8::StaticOrder S; S.init(M, 1024, G, (int)blockIdx.x);
          pg8::EpiResid E{Xres, Y, ALPHA};
          pg8::gemm_phase<pg8::EpiResid, false>(lds, g, S, E); }
        grid.sync();
        ln_phase(Y, a.in[5] + (size_t)l * D, a.in[6] + (size_t)l * D, a.out, XN, gw, NGW, lane);
        grid.sync();
        { pg8::Gemm g{XN, (const bf16*)(wl + WO_GU), M, 2 * DFF, 1024}; pg8::StaticOrder S; S.init(M, 2 * DFF, G, (int)blockIdx.x);
          pg8::EpiSwiglu E{H};
          pg8::gemm_phase<pg8::EpiSwiglu, true>(lds, g, S, E); }
        grid.sync();
        { pg8::Gemm g{H, (const bf16*)(wl + WO_DN), M, 1024, DFF}; pg8::StaticOrder S; S.init(M, 1024, G, (int)blockIdx.x);
          pg8::EpiResid E{a.out, Y2, ALPHA};
          pg8::gemm_phase<pg8::EpiResid, false>(lds, g, S, E); }
        grid.sync();
        ln_phase(Y2, a.in[10] + (size_t)l * D, a.in[11] + (size_t)l * D, a.out, XN, gw, NGW, lane);
        if (l + 1 < DEPTH) grid.sync();
    }
}

extern "C" void kernel_launch(void* const* d_in, const int* in_sizes, int n_in, void* d_out, int out_size, void* d_ws, size_t ws_size, hipStream_t stream) {
    static int grid = 0;
    if (grid == 0) {
        if (n_in != 12 || in_sizes[0] != M * D || out_size != M * D || ws_size < WS_END) { fprintf(stderr, "kernel_launch: unexpected problem shape (n_in %d, ws %zu); nothing launched\n", n_in, ws_size); grid = -1; return; }
        int dev = 0, cus = 0, per_cu = 0;
        if (hipGetDevice(&dev) != hipSuccess || hipDeviceGetAttribute(&cus, hipDeviceAttributeMultiprocessorCount, dev) != hipSuccess) { grid = -1; return; }
        if (hipFuncSetAttribute((const void*)fwd_megakernel, hipFuncAttributeMaxDynamicSharedMemorySize, LDS_BYTES) != hipSuccess) { fprintf(stderr, "kernel_launch: hipFuncSetAttribute failed\n"); grid = -1; return; }
        if (hipOccupancyMaxActiveBlocksPerMultiprocessor(&per_cu, (const void*)fwd_megakernel, NTHREADS, LDS_BYTES) != hipSuccess || per_cu < 1) per_cu = 1;
        (void)hipGetLastError();
        grid = cus;
        (void)per_cu;
    }
    if (grid < 0) return;
    Args a{};
    for (int i = 0; i < 12; ++i) a.in[i] = (const float*)d_in[i];
    a.out = (float*)d_out; a.ws = (unsigned char*)d_ws;
    void* args[] = {&a};
    hipError_t e = hipLaunchCooperativeKernel((const void*)fwd_megakernel, dim3(grid), dim3(NTHREADS), args, LDS_BYTES, stream);
    if (e != hipSuccess) fprintf(stderr, "cooperative launch failed: %s (grid %d)\n", hipGetErrorString(e), grid);
}
```

```cpp
#include <hip/hip_runtime.h>
#include <hip/hip_cooperative_groups.h>
#include <cstdio>
#include <cstdint>
namespace cg = cooperative_groups;

namespace pg8 {
#define PG8_LAS __attribute__((address_space(3)))
typedef unsigned short bf16_t;
typedef short bf16x8 __attribute__((ext_vector_type(8)));
typedef float f32x4 __attribute__((ext_vector_type(4)));
typedef float f32x2 __attribute__((ext_vector_type(2)));
typedef unsigned u32x4 __attribute__((ext_vector_type(4)));
constexpr int BM = 256, BK = 64, HALF = 128, HTB = HALF * BK * 2, STAGE_BYTES = 8 * HTB, NXCD = 8, WGM = 8;

__host__ __device__ __forceinline__ int lds_byte(int r, int c) { const int st = (r >> 4) * 2 + (c >> 5), rr = r & 15, cc = c & 31, ob = rr * 64 + cc * 2; return st * 1024 + (ob ^ (((ob >> 9) & 1) << 5)); }
__host__ __device__ __forceinline__ void stage_rc(int b, int& R, int& C) { const int st = b / 1024, sb = b % 1024, swz = sb ^ (((sb >> 9) & 1) << 5); R = (st >> 1) * 16 + swz / 64; C = (st & 1) * 32 + (swz % 64) / 2; }
__host__ __device__ __forceinline__ int perm32(int rho) { const int n = rho >> 4, i = rho & 15; return 8 * (i >> 2) + 4 * n + (i & 3); }

struct Unit { int pm, pn; };
struct Gemm { const bf16_t* A; const bf16_t* Bt; int M, N, K; };

struct StaticOrder {
    int nM, nN, nwg, G, c;
    __host__ __device__ void init(int M, int N, int G_, int c_) { nM = M / BM; nN = N / BM; nwg = nM * nN; G = G_; c = c_; }
    __host__ __device__ bool next(int i, Unit& u) const {
        const long L = (long)i * G + c; if (L >= nwg) return false;
        int wgid = (int)L; { const int q = nwg / NXCD, r = nwg % NXCD, xcd = wgid % NXCD, off = wgid / NXCD; wgid = (xcd < r ? xcd * (q + 1) : r * (q + 1) + (xcd - r) * q) + off; }
        const int nig = WGM * nN, gid = wgid / nig, fm = gid * WGM, gsz = (nM - fm) < WGM ? (nM - fm) : WGM;
        u.pm = fm + ((wgid % nig) % gsz); u.pn = (wgid % nig) / gsz; return true;
    }
};

__device__ __forceinline__ unsigned cvt_pk_bf16(float lo, float hi) { unsigned r; asm volatile("v_cvt_pk_bf16_f32 %0, %1, %2" : "=v"(r) : "v"(lo), "v"(hi)); return r; }
__device__ __forceinline__ float bf_lo(unsigned w) { return __uint_as_float(w << 16); }
__device__ __forceinline__ float bf_hi(unsigned w) { return __uint_as_float(w & 0xffff0000u); }
__device__ __forceinline__ float sigmoidf_(float x) { return 1.0f / (1.0f + __expf(-x)); }

typedef f32x4 Acc[2][2][4][2];

struct EpiBf16 {
    static constexpr bool PERM = true, MID = false;
    bf16_t* O; int ldc;
    __device__ __forceinline__ void mid(Acc&, const Unit&, int, int, int, int) const {}
    __device__ __forceinline__ void operator()(Acc& acc, const Unit& u, int wr, int wc, int fr, int fq) const {
        const int row0 = u.pm * BM + wr * 64 + fr, col0 = u.pn * BM + wc * 32 + 8 * fq;
#pragma unroll
        for (int ai = 0; ai < 2; ++ai)
#pragma unroll
            for (int m = 0; m < 4; ++m) { bf16_t* rowp = O + (size_t)(row0 + ai * HALF + m * 16) * ldc + col0;
#pragma unroll
                for (int bj = 0; bj < 2; ++bj) { const f32x4 v0 = acc[ai][bj][m][0], v1 = acc[ai][bj][m][1];
                    u32x4 w; w.x = cvt_pk_bf16(v0[0], v0[1]); w.y = cvt_pk_bf16(v0[2], v0[3]); w.z = cvt_pk_bf16(v1[0], v1[1]); w.w = cvt_pk_bf16(v1[2], v1[3]);
                    *(u32x4*)(rowp + bj * HALF) = w; } }
    }
};

struct EpiInProj {
    static constexpr bool PERM = true, MID = false;
    bf16_t* QK; bf16_t* G; const float* rope; float* kpart;
    __device__ __forceinline__ void mid(Acc&, const Unit&, int, int, int, int) const {}
    __device__ __forceinline__ void operator()(Acc& acc, const Unit& u, int wr, int wc, int fr, int fq) const {
        const int pn = u.pn, seg = pn >> 1;
        const int row0 = u.pm * BM + wr * 64 + fr;
        bf16_t* base = pn < 8 ? QK : G; const int colt = (pn < 8 ? pn : pn - 8) * BM;
        const int col0 = colt + wc * 32 + 8 * fq;
        const float sc = (pn < 8 && (seg == 0 || seg == 2)) ? 0.125f : 1.0f;
        const bool do_rope = pn >= 4 && pn < 8 && (wc & 1) == 0;
        const bool do_sum = pn >= 6 && pn < 8;
        f32x4 cs_[2][2];
#pragma unroll
        for (int bj = 0; bj < 2; ++bj)
#pragma unroll
            for (int n = 0; n < 2; ++n) cs_[bj][n] = (f32x4){0.f, 0.f, 0.f, 0.f};
#pragma unroll
        for (int ai = 0; ai < 2; ++ai)
#pragma unroll
            for (int m = 0; m < 4; ++m) { const int row = row0 + ai * HALF + m * 16;
                if (do_rope) { const f32x4* cs = (const f32x4*)(rope + (size_t)(row & 8191) * 16);
                    const f32x4 c0 = cs[0], c1 = cs[1], c2 = cs[2], c3 = cs[3];
                    const f32x4 cosA = {c0[0], c0[2], c1[0], c1[2]}, cosB = {c2[0], c2[2], c3[0], c3[2]}, sinA = {c0[1], c0[3], c1[1], c1[3]}, sinB = {c2[1], c2[3], c3[1], c3[3]};
#pragma unroll
                    for (int bj = 0; bj < 2; ++bj)
#pragma unroll
                        for (int n = 0; n < 2; ++n) { const f32x4 v = acc[ai][bj][m][n]; f32x4 p;
#pragma unroll
                            for (int i = 0; i < 4; ++i) p[i] = __shfl_xor(v[i], 16);
                            const f32x4 c = n == 0 ? cosA : cosB, sn = n == 0 ? sinA : sinB;
                            const f32x4 r = fq == 0 ? v * c - p * sn : v * c + p * sn;
                            if (fq < 2) acc[ai][bj][m][n] = r; } }
                bf16_t* rowp = base + (size_t)row * 2048 + col0;
#pragma unroll
                for (int bj = 0; bj < 2; ++bj) { cs_[bj][0] += acc[ai][bj][m][0]; cs_[bj][1] += acc[ai][bj][m][1];
                    const f32x4 v0 = acc[ai][bj][m][0] * sc, v1 = acc[ai][bj][m][1] * sc;
                    u32x4 w; w.x = cvt_pk_bf16(v0[0], v0[1]); w.y = cvt_pk_bf16(v0[2], v0[3]); w.z = cvt_pk_bf16(v1[0], v1[1]); w.w = cvt_pk_bf16(v1[2], v1[3]);
                    *(u32x4*)(rowp + bj * HALF) = w; }
                asm volatile("" ::: "memory"); }
        if (do_sum) {
#pragma unroll
            for (int bj = 0; bj < 2; ++bj)
#pragma unroll
                for (int n = 0; n < 2; ++n) { f32x4 s = cs_[bj][n];
#pragma unroll
                    for (int i = 0; i < 4; ++i) { float t = s[i]; t += __shfl_xor(t, 1); t += __shfl_xor(t, 2); t += __shfl_xor(t, 4); t += __shfl_xor(t, 8); s[i] = t; }
                    if (fr == 0) *(f32x4*)(kpart + ((size_t)u.pm * 2 + wr) * 512 + (pn - 6) * BM + bj * HALF + wc * 32 + 8 * fq + 4 * n) = s; }
        }
    }
};

struct EpiMerged {
    static constexpr bool PERM = true, MID = true;
    const bf16_t* G; bf16_t* O;
    __device__ __forceinline__ void mid(Acc& acc, const Unit& u, int wr, int wc, int fr_, int fq) const {
        int fr = fr_; asm volatile("" : "+v"(fr));
        const int row0 = u.pm * BM + wr * 64 + fr, col0 = u.pn * BM + wc * 32 + 8 * fq;
#pragma unroll
        for (int ai = 0; ai < 2; ++ai)
#pragma unroll
            for (int m = 0; m < 4; ++m) { const bf16_t* gp = G + (size_t)(row0 + ai * HALF + m * 16) * 2048 + col0;
#pragma unroll
                for (int bj = 0; bj < 2; ++bj) { const u32x4 a = *(const u32x4*)(gp + bj * HALF), b = *(const u32x4*)(gp + 1024 + bj * HALF);
#pragma unroll
                    for (int j = 0; j < 4; ++j) { const float a0 = bf_lo(a[j]), a1 = bf_hi(a[j]), b0 = fmaxf(bf_lo(b[j]), -60.f), b1 = fmaxf(bf_hi(b[j]), -60.f);
                        const float r0 = sigmoidf_(a0) * (1.0f + __expf(-b0)), r1 = sigmoidf_(a1) * (1.0f + __expf(-b1));
                        acc[ai][bj][m][j >> 1][(j & 1) * 2] *= r0; acc[ai][bj][m][j >> 1][(j & 1) * 2 + 1] *= r1; } }
                asm volatile("" ::: "memory"); }
    }
    __device__ __forceinline__ void operator()(Acc& acc, const Unit& u, int wr, int wc, int fr, int fq) const {
        const int row0 = u.pm * BM + wr * 64 + fr, col0 = u.pn * BM + wc * 32 + 8 * fq;
#pragma unroll
        for (int ai = 0; ai < 2; ++ai)
#pragma unroll
            for (int m = 0; m < 4; ++m) { const size_t r = (size_t)(row0 + ai * HALF + m * 16);
#pragma unroll
                for (int bj = 0; bj < 2; ++bj) { const u32x4 b = *(const u32x4*)(G + r * 2048 + 1024 + col0 + bj * HALF);
                    float o[8];
#pragma unroll
                    for (int j = 0; j < 4; ++j) { const float b0 = fmaxf(bf_lo(b[j]), -60.f), b1 = fmaxf(bf_hi(b[j]), -60.f);
                        o[2 * j] = acc[ai][bj][m][j >> 1][(j & 1) * 2] * sigmoidf_(b0); o[2 * j + 1] = acc[ai][bj][m][j >> 1][(j & 1) * 2 + 1] * sigmoidf_(b1); }
                    u32x4 w; w.x = cvt_pk_bf16(o[0], o[1]); w.y = cvt_pk_bf16(o[2], o[3]); w.z = cvt_pk_bf16(o[4], o[5]); w.w = cvt_pk_bf16(o[6], o[7]);
                    *(u32x4*)(O + r * 1024 + col0 + bj * HALF) = w; }
                asm volatile("" ::: "memory"); }
    }
};

struct EpiResid {
    static constexpr bool PERM = false, MID = false;
    const float* X; float* Y; float alpha;
    __device__ __forceinline__ void mid(Acc&, const Unit&, int, int, int, int) const {}
    __device__ __forceinline__ void operator()(Acc& acc, const Unit& u, int wr, int wc, int fr, int fq) const {
        const int row0 = u.pm * BM + wr * 64 + fr, col0 = u.pn * BM + wc * 32 + 4 * fq;
#pragma unroll
        for (int ai = 0; ai < 2; ++ai)
#pragma unroll
            for (int m = 0; m < 4; ++m) { const size_t off = (size_t)(row0 + ai * HALF + m * 16) * 1024 + col0;
#pragma unroll
                for (int bj = 0; bj < 2; ++bj)
#pragma unroll
                    for (int n = 0; n < 2; ++n) { const f32x4 x = *(const f32x4*)(X + off + bj * HALF + n * 16);
                        *(f32x4*)(Y + off + bj * HALF + n * 16) = x * alpha + acc[ai][bj][m][n]; } }
    }
};

struct EpiSwiglu {
    static constexpr bool PERM = true, MID = false;
    bf16_t* H;
    __device__ __forceinline__ void mid(Acc&, const Unit&, int, int, int, int) const {}
    __device__ __forceinline__ void operator()(Acc& acc, const Unit& u, int wr, int wc, int fr, int fq) const {
        const int row0 = u.pm * BM + wr * 64 + fr, col0 = u.pn * HALF + wc * 32 + 8 * fq;
#pragma unroll
        for (int ai = 0; ai < 2; ++ai)
#pragma unroll
            for (int m = 0; m < 4; ++m) { float o[8];
#pragma unroll
                for (int n = 0; n < 2; ++n)
#pragma unroll
                    for (int i = 0; i < 4; ++i) { const float g = acc[ai][0][m][n][i], up = acc[ai][1][m][n][i]; o[4 * n + i] = g * sigmoidf_(g) * up; }
                u32x4 w; w.x = cvt_pk_bf16(o[0], o[1]); w.y = cvt_pk_bf16(o[2], o[3]); w.z = cvt_pk_bf16(o[4], o[5]); w.w = cvt_pk_bf16(o[6], o[7]);
                *(u32x4*)(H + (size_t)(row0 + ai * HALF + m * 16) * 2816 + col0) = w; }
    }
};

template <class Epi, bool ALIGN_EPI>
__device__ __forceinline__ void gemm_phase(PG8_LAS unsigned char* lds, const Gemm g, const StaticOrder& S, const Epi& E) {
    int tid_ = threadIdx.x; asm volatile("" : "+v"(tid_));
    const int tid = tid_, wid = __builtin_amdgcn_readfirstlane(tid >> 6), lane = tid & 63, wr = wid >> 2, wc = wid & 3, fr = lane & 15, fq = lane >> 4;
    const int K = g.K, nt = K / BK;
    unsigned voffA[2], voffB[2];
#pragma unroll
    for (int i = 0; i < 2; ++i) { int R, C; stage_rc(tid * 16 + i * 8192, R, C); const int Rb = Epi::PERM ? ((R & ~31) + perm32(R & 31)) : R;
        voffA[i] = (unsigned)(R * K + C) * 2u; voffB[i] = (unsigned)(Rb * K + C) * 2u; }
    const size_t kstep = (size_t)(BK * 2);
    const size_t hstep = (size_t)HALF * K * 2;
    const size_t tstep = 2 * hstep;
    const unsigned ldsw = (unsigned)wid * 1024u;
    const int aoff = lds_byte(wr * 64 + fr, fq * 8), boff = lds_byte(wc * 32 + fr, fq * 8);
#define PG8_SA(b, h) (((b) * 2 + (h)) * HTB)
#define PG8_SB(b, h) ((4 + (b) * 2 + (h)) * HTB)
#define PG8_STAGE(bufoff, gbase, voff) do { _Pragma("unroll") for (int _i = 0; _i < 2; ++_i) \
        __builtin_amdgcn_global_load_lds((const unsigned*)((const char*)(gbase) + (voff)[_i]), (PG8_LAS unsigned*)(lds + (bufoff) + ldsw + _i * 8192), 16, 0, 0); } while (0)
#define PG8_LDA(dst, b, h) do { _Pragma("unroll") for (int m = 0; m < 4; ++m) _Pragma("unroll") for (int k = 0; k < 2; ++k) dst[m][k] = *(const PG8_LAS bf16x8*)(lds + PG8_SA(b, h) + aoff + m * 2048 + k * 1024); } while (0)
#define PG8_LDB(dst, b, h) do { _Pragma("unroll") for (int n = 0; n < 2; ++n) _Pragma("unroll") for (int k = 0; k < 2; ++k) dst[n][k] = *(const PG8_LAS bf16x8*)(lds + PG8_SB(b, h) + boff + n * 2048 + k * 1024); } while (0)
#define PG8_MMA(ai, bj, At, Bt) do { __builtin_amdgcn_s_setprio(1); _Pragma("unroll") for (int m = 0; m < 4; ++m) _Pragma("unroll") for (int n = 0; n < 2; ++n) _Pragma("unroll") for (int k = 0; k < 2; ++k) \
        acc[ai][bj][m][n] = __builtin_amdgcn_mfma_f32_16x16x32_bf16(Bt[n][k], At[m][k], acc[ai][bj][m][n], 0, 0, 0); __builtin_amdgcn_s_setprio(0); } while (0)
#define PG8_WAIT_V(n) asm volatile("s_waitcnt vmcnt(" #n ")" ::: "memory")
#define PG8_WAIT_L(n) asm volatile("s_waitcnt lgkmcnt(" #n ")" ::: "memory")
#define PG8_BAR __builtin_amdgcn_s_barrier()
#define PG8_SCHED __builtin_amdgcn_sched_barrier(0)
    Unit cur, nxt; int ui = 0;
    if (!S.next(0, cur)) return;
    Acc acc;
#pragma unroll
    for (int a = 0; a < 2; ++a)
#pragma unroll
        for (int b = 0; b < 2; ++b)
#pragma unroll
            for (int m = 0; m < 4; ++m)
#pragma unroll
                for (int n = 0; n < 2; ++n) acc[a][b][m][n] = (f32x4){0.f, 0.f, 0.f, 0.f};
    bf16x8 At[4][2], B0[2][2], B1[2][2];
    const char* cA = (const char*)g.A + (size_t)cur.pm * tstep; const char* cB = (const char*)g.Bt + (size_t)cur.pn * tstep;
    PG8_STAGE(PG8_SB(0, 0), cB, voffB); PG8_STAGE(PG8_SB(0, 1), cB + hstep, voffB); PG8_STAGE(PG8_SA(0, 0), cA, voffA); PG8_STAGE(PG8_SA(0, 1), cA + hstep, voffA);
    if (wr == 1) PG8_BAR;
    PG8_WAIT_V(2); PG8_BAR;
    PG8_STAGE(PG8_SB(1, 0), cB + kstep, voffB); PG8_STAGE(PG8_SA(1, 0), cA + kstep, voffA); PG8_STAGE(PG8_SB(1, 1), cB + hstep + kstep, voffB);
    PG8_WAIT_V(6); PG8_BAR;
    for (;;) {
        const bool has_next = S.next(ui + 1, nxt);
        const char* nA = has_next ? (const char*)g.A + (size_t)nxt.pm * tstep : cA; const char* nB = has_next ? (const char*)g.Bt + (size_t)nxt.pn * tstep : cB;
        for (int t = 0; t < nt; t += 2) {
            if constexpr (Epi::MID) { if (t == nt / 2) E.mid(acc, cur, wr, wc, fr, fq); }
            const bool last = (t == nt - 2);
            const char* a1 = cA + (size_t)(t + 1) * kstep;
            const char* a2 = last ? nA : cA + (size_t)(t + 2) * kstep; const char* b2 = last ? nB : cB + (size_t)(t + 2) * kstep;
            const char* a3 = a2 + kstep; const char* b3 = b2 + kstep;
            PG8_LDB(B0, 0, 0); PG8_LDB(B1, 0, 1); PG8_SCHED; PG8_LDA(At, 0, 0); PG8_STAGE(PG8_SA(1, 1), a1 + hstep, voffA);
            PG8_WAIT_V(8); PG8_WAIT_L(0); PG8_BAR; PG8_MMA(0, 0, At, B0); PG8_MMA(0, 1, At, B1); PG8_BAR; PG8_SCHED;
            PG8_LDA(At, 0, 1); PG8_STAGE(PG8_SB(0, 0), b2, voffB); PG8_STAGE(PG8_SB(0, 1), b2 + hstep, voffB); PG8_STAGE(PG8_SA(0, 0), a2, voffA);
            PG8_WAIT_V(8); PG8_WAIT_L(0); PG8_BAR; PG8_MMA(1, 0, At, B0); PG8_MMA(1, 1, At, B1); PG8_BAR; PG8_SCHED;
            PG8_LDB(B0, 1, 0); PG8_LDB(B1, 1, 1); PG8_SCHED; PG8_LDA(At, 1, 0); PG8_STAGE(PG8_SA(0, 1), a2 + hstep, voffA);
            PG8_WAIT_V(8); PG8_WAIT_L(0); PG8_BAR; PG8_MMA(0, 0, At, B0); PG8_MMA(0, 1, At, B1); PG8_BAR; PG8_SCHED;
            PG8_LDA(At, 1, 1); PG8_STAGE(PG8_SB(1, 0), b3, voffB); PG8_STAGE(PG8_SB(1, 1), b3 + hstep, voffB); PG8_STAGE(PG8_SA(1, 0), a3, voffA);
            PG8_WAIT_V(8); PG8_WAIT_L(0); PG8_BAR; PG8_MMA(1, 0, At, B0); PG8_MMA(1, 1, At, B1); PG8_BAR; PG8_SCHED;
        }
        if constexpr (ALIGN_EPI) { if (wr == 0) PG8_BAR; }
        E(acc, cur, wr, wc, fr, fq);
        if (!has_next) break;
#pragma unroll
        for (int a = 0; a < 2; ++a)
#pragma unroll
            for (int b = 0; b < 2; ++b)
#pragma unroll
                for (int m = 0; m < 4; ++m)
#pragma unroll
                    for (int n = 0; n < 2; ++n) acc[a][b][m][n] = (f32x4){0.f, 0.f, 0.f, 0.f};
        cur = nxt; cA = nA; cB = nB; ++ui;
        if constexpr (ALIGN_EPI) { if (wr == 1) PG8_BAR; }
    }
    PG8_WAIT_V(0);
    if constexpr (!ALIGN_EPI) { if (wr == 0) PG8_BAR; }
    PG8_BAR;
#undef PG8_SA
#undef PG8_SB
#undef PG8_STAGE
#undef PG8_LDA
#undef PG8_LDB
#undef PG8_MMA
#undef PG8_WAIT_V
#undef PG8_WAIT_L
#undef PG8_BAR
#undef PG8_SCHED
}
}

constexpr int NWAVES = 8, NTHREADS = 512;
constexpr int BATCH = 2, SEQ = 8192, D = 1024, M = BATCH * SEQ, DFF = 2816, DEPTH = 2, HD = 64, NH = 8;
constexpr int IN_COLS = 5120;
constexpr float LN_EPS = 1e-5f;
constexpr float ALPHA = 1.41421356237309515f;

typedef unsigned short bf16;
typedef unsigned v4u __attribute__((ext_vector_type(4)));
typedef float f32x4 __attribute__((ext_vector_type(4)));
#define LAS __attribute__((address_space(3)))

constexpr size_t MiB = 1u << 20;
constexpr size_t WS_W = 0, W_LAYER = 31 * MiB;
constexpr size_t WO_MAIN = 0;
constexpr size_t WO_VT = WO_MAIN + (size_t)4096 * 1024 * 2;
constexpr size_t WO_BR = WO_VT + (size_t)1024 * 1024 * 2;
constexpr size_t WO_OUT = WO_BR + (size_t)1024 * 1024 * 2;
constexpr size_t WO_GU = WO_OUT + (size_t)1024 * 1024 * 2;
constexpr size_t WO_DN = WO_GU + (size_t)5632 * 1024 * 2;
static_assert(WO_DN + (size_t)1024 * 2816 * 2 <= W_LAYER, "weights per layer");
constexpr size_t WS_XN = 62 * MiB;
constexpr size_t WS_O = WS_XN;
constexpr size_t WS_QK = 94 * MiB;
constexpr size_t WS_MG = WS_QK, WS_H = WS_QK;
constexpr size_t WS_G = 158 * MiB;
constexpr size_t WS_Y = WS_G;
constexpr size_t WS_Y2 = 182 * MiB;
constexpr size_t WS_VT = 222 * MiB;
constexpr size_t WS_ROPE = 254 * MiB;
constexpr size_t WS_KPART = WS_ROPE + 512 * 1024;
constexpr size_t WS_BAR = 255 * MiB, BAR_ZERO_BYTES = 16384;
constexpr size_t WS_END = 256 * MiB;
static_assert(WS_H + (size_t)M * DFF * 2 <= WS_Y2 && WS_Y2 + (size_t)M * D * 4 <= WS_ROPE && WS_KPART + 64 * 2 * 512 * 4 <= WS_END, "d_ws map");

constexpr int RING_BYTES = 131072, LDS_BYTES = 147456;

__device__ __forceinline__ unsigned f2bf(float f) { unsigned u = __builtin_bit_cast(unsigned, f); return (u + 0x7fffu + ((u >> 16) & 1u)) >> 16; }
__device__ __forceinline__ unsigned pk2(float lo, float hi) { return f2bf(lo) | (f2bf(hi) << 16); }
__device__ __forceinline__ float bflo(unsigned w) { return __uint_as_float(w << 16); }
__device__ __forceinline__ float bfhi(unsigned w) { return __uint_as_float(w & 0xffff0000u); }
__device__ __forceinline__ float wave_sum(float v) {
#pragma unroll
    for (int o = 1; o < 64; o <<= 1) v += __shfl_xor(v, o);
    return v;
}

__device__ __forceinline__ void transpose_item(const float* W, int N, int kb, int nb, bf16* dst, int row0, int ld, int col_off, LAS float* scr, int lane) {
    const int k0 = 64 * kb, n0 = 32 * nb;
#pragma unroll 8
    for (int i = 0; i < 32; ++i) { const int kk = 2 * i + (lane >> 5); scr[kk * 33 + (lane & 31)] = W[(size_t)(k0 + kk) * N + n0 + (lane & 31)]; }
    asm volatile("s_waitcnt lgkmcnt(0)" ::: "memory");
    const int c = lane & 7;
#pragma unroll
    for (int j = 0; j < 4; ++j) { const int n = (lane >> 3) + 8 * j; const LAS float* s = scr + (8 * c) * 33 + n;
        v4u o; o.x = pk2(s[0 * 33], s[1 * 33]); o.y = pk2(s[2 * 33], s[3 * 33]); o.z = pk2(s[4 * 33], s[5 * 33]); o.w = pk2(s[6 * 33], s[7 * 33]);
        *(v4u*)(dst + (size_t)(row0 + n) * ld + col_off + k0 + 8 * c) = o; }
    asm volatile("s_waitcnt lgkmcnt(0)" ::: "memory");
}

struct Args { const float* in[12]; float* out; unsigned char* ws; };

__device__ __forceinline__ void prologue(const Args& a, LAS unsigned char* lds, int gw, int NGW, int wave, int lane) {
    LAS float* scr = (LAS float*)(lds + wave * 16384);
    constexpr int I_IN = 16 * 160, I_BR = 8 * 32, I_OUT = 16 * 32, I_G = 16 * 88, I_DN = 44 * 32;
    constexpr int PER_LAYER = I_IN + 2 * I_BR + I_OUT + 2 * I_G + I_DN;
    for (int it = gw; it < DEPTH * PER_LAYER; it += NGW) {
        const int l = it / PER_LAYER; int r = it % PER_LAYER;
        unsigned char* wl = a.ws + WS_W + (size_t)l * W_LAYER;
        if (r < I_IN) { const int kb = r / 160, nb = r % 160, c = nb * 32;
            bf16* dst; int row0;
            if (c < 1024) { dst = (bf16*)(wl + WO_MAIN); row0 = c; }
            else if (c < 1536) { dst = (bf16*)(wl + WO_VT); row0 = c - 1024; }
            else if (c < 2560) { dst = (bf16*)(wl + WO_MAIN); row0 = c - 1536 + 1024; }
            else if (c < 3072) { dst = (bf16*)(wl + WO_VT); row0 = c - 2560 + 512; }
            else { dst = (bf16*)(wl + WO_MAIN); row0 = c - 3072 + 2048; }
            transpose_item(a.in[1] + (size_t)l * 1024 * IN_COLS, IN_COLS, kb, nb, dst, row0, 1024, 0, scr, lane); continue; }
        r -= I_IN;
        if (r < I_BR) { transpose_item(a.in[2] + (size_t)l * 512 * 1024, 1024, r / 32, r % 32, (bf16*)(wl + WO_BR), (r % 32) * 32, 1024, 0, scr, lane); continue; }
        r -= I_BR;
        if (r < I_BR) { transpose_item(a.in[3] + (size_t)l * 512 * 1024, 1024, r / 32, r % 32, (bf16*)(wl + WO_BR), (r % 32) * 32, 1024, 512, scr, lane); continue; }
        r -= I_BR;
        if (r < I_OUT) { transpose_item(a.in[4] + (size_t)l * 1024 * 1024, 1024, r / 32, r % 32, (bf16*)(wl + WO_OUT), (r % 32) * 32, 1024, 0, scr, lane); continue; }
        r -= I_OUT;
        if (r < I_G) { const int nb = r % 88, c = nb * 32; transpose_item(a.in[7] + (size_t)l * 1024 * DFF, DFF, r / 88, nb, (bf16*)(wl + WO_GU), 256 * (c / 128) + (c % 128), 1024, 0, scr, lane); continue; }
        r -= I_G;
        if (r < I_G) { const int nb = r % 88, c = nb * 32; transpose_item(a.in[8] + (size_t)l * 1024 * DFF, DFF, r / 88, nb, (bf16*)(wl + WO_GU), 256 * (c / 128) + 128 + (c % 128), 1024, 0, scr, lane); continue; }
        r -= I_G;
        transpose_item(a.in[9] + (size_t)l * DFF * 1024, 1024, r / 32, r % 32, (bf16*)(wl + WO_DN), (r % 32) * 32, DFF, 0, scr, lane);
    }
    bf16* XN = (bf16*)(a.ws + WS_XN);
    for (int m = gw; m < M; m += NGW) { const f32x4* xr = (const f32x4*)(a.in[0] + (size_t)m * D) + lane; unsigned long long* o8 = (unsigned long long*)(XN + (size_t)m * D) + lane;
#pragma unroll
        for (int j = 0; j < 4; ++j) { const f32x4 v = xr[64 * j]; o8[64 * j] = (unsigned long long)pk2(v.x, v.y) | ((unsigned long long)pk2(v.z, v.w) << 32); } }
    float* rope = (float*)(a.ws + WS_ROPE);
    for (int e = gw * 64 + lane; e < SEQ * 8; e += NGW * 64) { const int pos = e >> 3, i = e & 7;
        const double ang = (double)pos * exp(-(double)i * 0.125 * log(500000.0));
        rope[2 * e] = (float)cos(ang); rope[2 * e + 1] = (float)sin(ang); }
}

__device__ __forceinline__ void ln_phase(const float* Y, const float* gam, const float* bet, float* X, bf16* XN, int gw, int NGW, int lane_) {
    int lane = lane_; asm volatile("" : "+v"(lane));
    for (int m = gw; m < M; m += NGW) {
        const f32x4* yr = (const f32x4*)(Y + (size_t)m * D) + lane;
        f32x4 v[4]; float s = 0.f;
#pragma unroll
        for (int j = 0; j < 4; ++j) { v[j] = yr[64 * j]; s += (v[j].x + v[j].y) + (v[j].z + v[j].w); }
        const float mean = wave_sum(s) * (1.f / D); float s2 = 0.f;
#pragma unroll
        for (int j = 0; j < 4; ++j) { v[j] = v[j] - mean; s2 += (v[j].x * v[j].x + v[j].y * v[j].y) + (v[j].z * v[j].z + v[j].w * v[j].w); }
        const float rstd = 1.f / sqrtf(wave_sum(s2) * (1.f / D) + LN_EPS);
        f32x4* xo = (f32x4*)(X + (size_t)m * D) + lane; unsigned long long* o8 = (unsigned long long*)(XN + (size_t)m * D) + lane;
#pragma unroll
        for (int j = 0; j < 4; ++j) { const f32x4 g = ((const f32x4*)gam)[lane + 64 * j], b = ((const f32x4*)bet)[lane + 64 * j];
            const f32x4 o = v[j] * rstd * g + b; xo[64 * j] = o;
            o8[64 * j] = (unsigned long long)pk2(o.x, o.y) | ((unsigned long long)pk2(o.z, o.w) << 32); }
    }
}

__device__ __forceinline__ float dot8(v4u q, v4u k) {
    return bflo(q.x) * bflo(k.x) + bfhi(q.x) * bfhi(k.x) + bflo(q.y) * bflo(k.y) + bfhi(q.y) * bfhi(k.y) + bflo(q.z) * bflo(k.z) + bfhi(q.z) * bfhi(k.z) + bflo(q.w) * bflo(k.w) + bfhi(q.w) * bfhi(k.w);
}
__device__ __forceinline__ float quad_sum(float v) { v += __shfl_xor(v, 1); v += __shfl_xor(v, 2); return v; }
__device__ __forceinline__ void dots8(float* z, v4u q0, v4u q1, const bf16* krow0_) {
    const bf16* krow0 = krow0_; asm volatile("" : "+v"(krow0));
#pragma unroll
    for (int i = 0; i < 8; ++i) { const bf16* kr = krow0 + (size_t)i * 2048;
        z[i] = quad_sum(dot8(q0, *(const v4u*)kr) + dot8(q1, *(const v4u*)(kr + 8))); }
}
__device__ __forceinline__ void accum_v8(float* o, const float* w, const bf16* vcol0_) {
    const bf16* vcol0 = vcol0_; asm volatile("" : "+v"(vcol0));
#pragma unroll
    for (int d = 0; d < 16; ++d) { const v4u v = *(const v4u*)(vcol0 + (size_t)d * M);
        o[d] += w[0] * bflo(v.x) + w[1] * bfhi(v.x) + w[2] * bflo(v.y) + w[3] * bfhi(v.y) + w[4] * bflo(v.z) + w[5] * bfhi(v.z) + w[6] * bflo(v.w) + w[7] * bfhi(v.w); }
}
__device__ __forceinline__ void store_o16(const float* o, float sc, bf16* p) {
#pragma unroll
    for (int c = 0; c < 2; ++c) { v4u w; w.x = pk2(o[8 * c] * sc, o[8 * c + 1] * sc); w.y = pk2(o[8 * c + 2] * sc, o[8 * c + 3] * sc); w.z = pk2(o[8 * c + 4] * sc, o[8 * c + 5] * sc); w.w = pk2(o[8 * c + 6] * sc, o[8 * c + 7] * sc);
        *(v4u*)(p + 8 * c) = w; }
}

__device__ __forceinline__ void sb_thread(const bf16* QK, const bf16* Vt, bf16* O, int b, int h, int q, int part) {
    const size_t row = (size_t)b * SEQ + q;
    const bf16* qp = QK + row * 2048 + h * 64 + part * 16;
    const v4u q0 = *(const v4u*)qp, q1 = *(const v4u*)(qp + 8);
    float o[16];
#pragma unroll
    for (int d = 0; d < 16; ++d) o[d] = 0.f;
    float c = 0.f;
    const bf16* Kb = QK + (size_t)b * SEQ * 2048 + 512 + h * 64 + part * 16;
    const bf16* Vb = Vt + (size_t)(h * 64 + part * 16) * M + (size_t)b * SEQ;
    for (int s0 = (q - 1) & ~7; s0 >= 0 && q > 0; s0 -= 8) {
        float z[8], w[8]; dots8(z, q0, q1, Kb + (size_t)s0 * 2048);
#pragma unroll
        for (int i = 7; i >= 0; --i) {
            const float zz = z[i]; const float l1p = __logf(1.0f + __expf(-fabsf(zz)));
            const float lk = -(fmaxf(zz, 0.f) + l1p), ls = fminf(zz, 0.f) - l1p;
            const bool past = (s0 + i) < q;
            w[i] = past ? __expf(ls + c) : 0.f; c += past ? lk : 0.f; }
        accum_v8(o, w, Vb + s0);
        if (c < -88.0f) break;
    }
    store_o16(o, 1.0f, O + row * 1024 + h * 64 + part * 16);
}

__device__ __forceinline__ void moba_chunk(float* o, float& mrun, float& lrun, v4u q0, v4u q1, const bf16* Kb, const bf16* Vb, int s0, int q) {
    float z[8]; dots8(z, q0, q1, Kb + (size_t)s0 * 2048);
    float mx = -INFINITY;
#pragma unroll
    for (int i = 0; i < 8; ++i) { if (s0 + i > q) z[i] = -INFINITY; mx = fmaxf(mx, z[i]); }
    const float mnew = fmaxf(mrun, mx), al = __expf(mrun - mnew);
    float w[8], ps = 0.f;
#pragma unroll
    for (int i = 0; i < 8; ++i) { w[i] = __expf(z[i] - mnew); ps += w[i]; }
    lrun = lrun * al + ps; mrun = mnew;
#pragma unroll
    for (int d = 0; d < 16; ++d) o[d] *= al;
    accum_v8(o, w, Vb + s0);
}

__device__ __forceinline__ void moba_thread(const bf16* QK, const bf16* Vt, bf16* O, const LAS float* kmean, int b, int h, int q, int part) {
    const size_t row = (size_t)b * SEQ + q;
    const bf16* qp = QK + row * 2048 + 1024 + h * 64 + part * 16;
    const v4u q0 = *(const v4u*)qp, q1 = *(const v4u*)(qp + 8);
    const int own = q >> 8;
    float v1 = -INFINITY, v2 = -INFINITY, v3 = -INFINITY; int i1 = 0, i2 = 0, i3 = 0;
    for (int j = 0; j < own; ++j) { const LAS float* k8 = kmean + j * 64 + part * 16;
        float g = bflo(q0.x) * k8[0] + bfhi(q0.x) * k8[1] + bflo(q0.y) * k8[2] + bfhi(q0.y) * k8[3] + bflo(q0.z) * k8[4] + bfhi(q0.z) * k8[5] + bflo(q0.w) * k8[6] + bfhi(q0.w) * k8[7]
                + bflo(q1.x) * k8[8] + bfhi(q1.x) * k8[9] + bflo(q1.y) * k8[10] + bfhi(q1.y) * k8[11] + bflo(q1.z) * k8[12] + bfhi(q1.z) * k8[13] + bflo(q1.w) * k8[14] + bfhi(q1.w) * k8[15];
        g = quad_sum(g);
        if (g > v1) { v3 = v2; i3 = i2; v2 = v1; i2 = i1; v1 = g; i1 = j; }
        else if (g > v2) { v3 = v2; i3 = i2; v2 = g; i2 = j; }
        else if (g > v3) { v3 = g; i3 = j; } }
    const int nsel = own < 3 ? own : 3;
    float o[16];
#pragma unroll
    for (int d = 0; d < 16; ++d) o[d] = 0.f;
    float mrun = -INFINITY, lrun = 0.f;
    const bf16* Kb = QK + (size_t)b * SEQ * 2048 + 1536 + h * 64 + part * 16;
    const bf16* Vb = Vt + (size_t)(512 + h * 64 + part * 16) * M + (size_t)b * SEQ;
    for (int t = 0; t < nsel; ++t) { const int blk = t == 0 ? i1 : (t == 1 ? i2 : i3);
        for (int s0 = blk * 256; s0 < blk * 256 + 256; s0 += 8) moba_chunk(o, mrun, lrun, q0, q1, Kb, Vb, s0, q); }
    for (int s0 = own * 256; s0 <= q; s0 += 8) moba_chunk(o, mrun, lrun, q0, q1, Kb, Vb, s0, q);
    store_o16(o, 1.0f / lrun, O + row * 1024 + 512 + h * 64 + part * 16);
}

typedef short bf16x8_t __attribute__((ext_vector_type(8)));
typedef float f32x16 __attribute__((ext_vector_type(16)));
__device__ __forceinline__ unsigned cvtpk(float lo, float hi) { unsigned r; asm volatile("v_cvt_pk_bf16_f32 %0, %1, %2" : "=v"(r) : "v"(lo), "v"(hi)); return r; }
__device__ __forceinline__ bf16x8_t pack8(const float* w) { v4u p; p.x = cvtpk(w[0], w[1]); p.y = cvtpk(w[2], w[3]); p.z = cvtpk(w[4], w[5]); p.w = cvtpk(w[6], w[7]); return __builtin_bit_cast(bf16x8_t, p); }
constexpr float SB_STOP = -88.0f;

__device__ __forceinline__ void sb_wave(const bf16* QK, const bf16* Vt, bf16* O, int b, int h, int qt, int lane) {
    const int n = lane & 31, hi = lane >> 5;
    const size_t rowq = (size_t)b * SEQ + qt * 32 + n;
    bf16x8_t qf[4];
#pragma unroll
    for (int d0 = 0; d0 < 4; ++d0) qf[d0] = *(const bf16x8_t*)(QK + rowq * 2048 + h * 64 + 16 * d0 + 8 * hi);
    const int pr = (n & ~12) | ((n & 4) << 1) | ((n & 8) >> 1);
    const bf16* Kb = QK + ((size_t)b * SEQ + pr) * 2048 + 512 + h * 64 + 8 * hi;
    const bf16* Vb = Vt + (size_t)(h * 64 + n) * M + (size_t)b * SEQ + 8 * hi;
    f32x16 o0 = {}, o1 = {};
    float c = 0.f;
    for (int kt = qt; kt >= 0; --kt) {
        const bf16* kp = Kb + (size_t)kt * 32 * 2048;
        bf16x8_t kf[4];
#pragma unroll
        for (int d0 = 0; d0 < 4; ++d0) kf[d0] = *(const bf16x8_t*)(kp + 16 * d0);
        const bf16* vp = Vb + kt * 32;
        const bf16x8_t v00 = *(const bf16x8_t*)(vp), v01 = *(const bf16x8_t*)(vp + 16), v10 = *(const bf16x8_t*)(vp + (size_t)32 * M), v11 = *(const bf16x8_t*)(vp + (size_t)32 * M + 16);
        f32x16 s = {};
#pragma unroll
        for (int d0 = 0; d0 < 4; ++d0) s = __builtin_amdgcn_mfma_f32_32x32x16_bf16(kf[d0], qf[d0], s, 0, 0, 0);
        float lk[16], ls[16];
        const bool diag = (kt == qt);
#pragma unroll
        for (int r = 0; r < 16; ++r) { const float zz = s[r]; const float l1p = __logf(1.0f + __expf(-fabsf(zz)));
            const bool past = !diag || (16 * (r >> 3) + 8 * hi + (r & 7)) < n;
            lk[r] = past ? -(fmaxf(zz, 0.f) + l1p) : 0.f; ls[r] = past ? fminf(zz, 0.f) - l1p : -INFINITY; }
        const float G0 = ((lk[0] + lk[1]) + (lk[2] + lk[3])) + ((lk[4] + lk[5]) + (lk[6] + lk[7])), G1 = ((lk[8] + lk[9]) + (lk[10] + lk[11])) + ((lk[12] + lk[13]) + (lk[14] + lk[15]));
        const float oG0 = __shfl_xor(G0, 32), oG1 = __shfl_xor(G1, 32);
        const float tailA = c + (hi == 0 ? (oG0 + G1) + oG1 : G1 + oG1), tailB = c + (hi == 0 ? oG1 : 0.f);
        float w[16]; float run = 0.f;
#pragma unroll
        for (int r = 7; r >= 0; --r) { w[r] = __expf(ls[r] + (run + tailA)); run += lk[r]; }
        run = 0.f;
#pragma unroll
        for (int r = 15; r >= 8; --r) { w[r] = __expf(ls[r] + (run + tailB)); run += lk[r]; }
        c += (G0 + oG0) + (G1 + oG1);
        const bf16x8_t pa0 = pack8(w), pa1 = pack8(w + 8);
        o0 = __builtin_amdgcn_mfma_f32_32x32x16_bf16(v00, pa0, o0, 0, 0, 0); o0 = __builtin_amdgcn_mfma_f32_32x32x16_bf16(v01, pa1, o0, 0, 0, 0);
        o1 = __builtin_amdgcn_mfma_f32_32x32x16_bf16(v10, pa0, o1, 0, 0, 0); o1 = __builtin_amdgcn_mfma_f32_32x32x16_bf16(v11, pa1, o1, 0, 0, 0);
        if (__all(c < SB_STOP)) break;
    }
    bf16* op = O + rowq * 1024 + h * 64 + 4 * hi;
#pragma unroll
    for (int g4 = 0; g4 < 4; ++g4) {
        unsigned long long a = (unsigned long long)cvtpk(o0[4 * g4], o0[4 * g4 + 1]) | ((unsigned long long)cvtpk(o0[4 * g4 + 2], o0[4 * g4 + 3]) << 32);
        unsigned long long c1 = (unsigned long long)cvtpk(o1[4 * g4], o1[4 * g4 + 1]) | ((unsigned long long)cvtpk(o1[4 * g4 + 2], o1[4 * g4 + 3]) << 32);
        *(unsigned long long*)(op + 8 * g4) = a; *(unsigned long long*)(op + 32 + 8 * g4) = c1; }
}

constexpr float LOG2E = 1.4426950408889634f;
constexpr int ML_KM = 0, ML_CNT = 8192, ML_CTR = ML_CNT + 128, ML_NGRP = ML_CTR + 4, ML_GRP = ML_CNT + 256, ML_LIST = ML_CNT + 1024, ML_PL = ML_LIST + 32 * 256 * 2, ML_PO = ML_PL + 256 * 4 * 4, ML_END = ML_PO + 256 * 3 * 64 * 2;
static_assert(ML_END <= 131072, "MoBA LDS map");
struct Flash { float m, l; f32x16 o0, o1; };
__device__ __forceinline__ void flash_tile(Flash& st, const bf16x8_t* qf, const bf16* kp, const bf16* vp, bool diag, int n, int hi) {
    bf16x8_t kf[4];
#pragma unroll
    for (int d0 = 0; d0 < 4; ++d0) kf[d0] = *(const bf16x8_t*)(kp + 16 * d0);
    const bf16x8_t v00 = *(const bf16x8_t*)(vp), v01 = *(const bf16x8_t*)(vp + 16), v10 = *(const bf16x8_t*)(vp + (size_t)32 * M), v11 = *(const bf16x8_t*)(vp + (size_t)32 * M + 16);
    f32x16 s = {};
#pragma unroll
    for (int d0 = 0; d0 < 4; ++d0) s = __builtin_amdgcn_mfma_f32_32x32x16_bf16(kf[d0], qf[d0], s, 0, 0, 0);
    float p[16]; float tmax = -INFINITY;
#pragma unroll
    for (int r = 0; r < 16; ++r) { float v = s[r] * LOG2E; if (diag && (16 * (r >> 3) + 8 * hi + (r & 7)) > n) v = -INFINITY; p[r] = v; tmax = fmaxf(tmax, v); }
    tmax = fmaxf(tmax, __shfl_xor(tmax, 32));
    const float mnew = fmaxf(st.m, tmax), alpha = __builtin_amdgcn_exp2f(st.m - mnew);
    float rs = 0.f;
#pragma unroll
    for (int r = 0; r < 16; ++r) { p[r] = __builtin_amdgcn_exp2f(p[r] - mnew); rs += p[r]; }
    rs += __shfl_xor(rs, 32);
    st.l = st.l * alpha + rs; st.m = mnew;
    st.o0 *= alpha; st.o1 *= alpha;
    const bf16x8_t pa0 = pack8(p), pa1 = pack8(p + 8);
    st.o0 = __builtin_amdgcn_mfma_f32_32x32x16_bf16(v00, pa0, st.o0, 0, 0, 0); st.o0 = __builtin_amdgcn_mfma_f32_32x32x16_bf16(v01, pa1, st.o0, 0, 0, 0);
    st.o1 = __builtin_amdgcn_mfma_f32_32x32x16_bf16(v10, pa0, st.o1, 0, 0, 0); st.o1 = __builtin_amdgcn_mfma_f32_32x32x16_bf16(v11, pa1, st.o1, 0, 0, 0);
}
__device__ __forceinline__ void split_bf16x8(const LAS float* src, bf16x8_t& hi8, bf16x8_t& lo8) {
    float x[8], lo[8];
#pragma unroll
    for (int i = 0; i < 8; ++i) x[i] = src[i];
    v4u h; h.x = cvtpk(x[0], x[1]); h.y = cvtpk(x[2], x[3]); h.z = cvtpk(x[4], x[5]); h.w = cvtpk(x[6], x[7]);
    lo[0] = x[0] - bflo(h.x); lo[1] = x[1] - bfhi(h.x); lo[2] = x[2] - bflo(h.y); lo[3] = x[3] - bfhi(h.y); lo[4] = x[4] - bflo(h.z); lo[5] = x[5] - bfhi(h.z); lo[6] = x[6] - bflo(h.w); lo[7] = x[7] - bfhi(h.w);
    hi8 = __builtin_bit_cast(bf16x8_t, h); lo8 = pack8(lo);
}

__device__ __forceinline__ void moba_unit(const bf16* QK, const bf16* Vt, bf16* O, const float* kpart, LAS unsigned char* lds, int b, int h, int qb, int tid) {
    const int lane = tid & 63, n = lane & 31, hi = lane >> 5, w = __builtin_amdgcn_readfirstlane(tid >> 6);
    LAS float* kmean = (LAS float*)(lds + ML_KM); LAS unsigned* cnt = (LAS unsigned*)(lds + ML_CNT); LAS unsigned* ctr = (LAS unsigned*)(lds + ML_CTR); LAS unsigned* ngrp = (LAS unsigned*)(lds + ML_NGRP);
    LAS unsigned* grp = (LAS unsigned*)(lds + ML_GRP); LAS unsigned short* list = (LAS unsigned short*)(lds + ML_LIST); LAS float* partL = (LAS float*)(lds + ML_PL); LAS bf16* partO = (LAS bf16*)(lds + ML_PO);
    __syncthreads();
    if (tid < 64) cnt[tid] = 0u;
    for (int e = tid; e < 32 * 64; e += NTHREADS) { const int j = e >> 6, d = e & 63; const float* kp = kpart + ((size_t)(b * 32 + j) * 2) * 512 + h * 64 + d;
        kmean[e] = (kp[0] + kp[512]) * (1.0f / 256.0f); }
    __syncthreads();
    const int pr = (n & ~12) | ((n & 4) << 1) | ((n & 8) >> 1);
    const bf16* Kb = QK + ((size_t)b * SEQ + pr) * 2048 + 1536 + h * 64 + 8 * hi;
    const bf16* Vb = Vt + (size_t)(512 + h * 64 + n) * M + (size_t)b * SEQ + 8 * hi;
    const bf16* Qb = QK + ((size_t)b * SEQ + qb * 256) * 2048 + 1024 + h * 64 + 8 * hi;
    const int qloc = w * 32 + n;
    bf16x8_t qf[4];
#pragma unroll
    for (int d0 = 0; d0 < 4; ++d0) qf[d0] = *(const bf16x8_t*)(Qb + (size_t)qloc * 2048 + 16 * d0);
    if (qb > 0) {
        f32x16 g = {};
#pragma unroll
        for (int d0 = 0; d0 < 4; ++d0) { bf16x8_t kh, kl; split_bf16x8(kmean + n * 64 + 16 * d0 + 8 * hi, kh, kl);
            g = __builtin_amdgcn_mfma_f32_32x32x16_bf16(kh, qf[d0], g, 0, 0, 0); g = __builtin_amdgcn_mfma_f32_32x32x16_bf16(kl, qf[d0], g, 0, 0, 0); }
        float gv[16];
#pragma unroll
        for (int r = 0; r < 16; ++r) { const int j = (r & 3) + 8 * (r >> 2) + 4 * hi; gv[r] = j < qb ? g[r] : -INFINITY; }
#pragma unroll
        for (int t = 0; t < 3; ++t) {
            float bv = -INFINITY; int bj = 64;
#pragma unroll
            for (int r = 0; r < 16; ++r) { const int j = (r & 3) + 8 * (r >> 2) + 4 * hi; if (gv[r] > bv) { bv = gv[r]; bj = j; } }
            const float pv = __shfl_xor(bv, 32); const int pj = __shfl_xor(bj, 32);
            if (pv > bv || (pv == bv && pj < bj)) { bv = pv; bj = pj; }
#pragma unroll
            for (int r = 0; r < 16; ++r) { const int j = (r & 3) + 8 * (r >> 2) + 4 * hi; if (j == bj) gv[r] = -INFINITY; }
            if (hi == 0 && bv > -INFINITY) { const unsigned pos = __hip_atomic_fetch_add(cnt + bj, 1u, __ATOMIC_RELAXED, __HIP_MEMORY_SCOPE_WORKGROUP);
                list[bj * 256 + pos] = (unsigned short)(qloc | (t << 8)); }
        }
    }
    __syncthreads();
    if (w == 0) { const unsigned c = n < qb ? cnt[n] : 0u; const int ng = hi == 0 ? (int)((c + 31u) >> 5) : 0;
        int incl = ng;
#pragma unroll
        for (int o = 1; o < 32; o <<= 1) { const int t = __shfl_up(incl, o); if (n >= o) incl += t; }
        const int base = incl - ng;
        if (hi == 0) { for (int k = 0; k < ng; ++k) grp[base + k] = (unsigned)n | ((unsigned)(k * 32) << 8); if (n == 31) ngrp[0] = (unsigned)incl; } }
    Flash own; own.m = -INFINITY; own.l = 0.f; own.o0 = (f32x16){}; own.o1 = (f32x16){};
    for (int kt = 0; kt <= w; ++kt) flash_tile(own, qf, Kb + (size_t)(qb * 256 + kt * 32) * 2048, Vb + qb * 256 + kt * 32, kt == w, n, hi);
    __syncthreads();
    const unsigned NG = ngrp[0];
    for (;;) {
        unsigned gi = 0; if (lane == 0) gi = __hip_atomic_fetch_add(ctr, 1u, __ATOMIC_RELAXED, __HIP_MEMORY_SCOPE_WORKGROUP);
        gi = __builtin_amdgcn_readfirstlane(gi);
        if (gi >= NG) break;
        const unsigned ge = grp[gi]; const int j = ge & 255, start = ge >> 8; const int cj = (int)cnt[j];
        const bool valid = start + n < cj;
        const unsigned e = list[j * 256 + (valid ? start + n : start)]; const int ql = e & 255, slot = e >> 8;
        bf16x8_t qg[4];
#pragma unroll
        for (int d0 = 0; d0 < 4; ++d0) qg[d0] = *(const bf16x8_t*)(Qb + (size_t)ql * 2048 + 16 * d0);
        Flash st; st.m = -INFINITY; st.l = 0.f; st.o0 = (f32x16){}; st.o1 = (f32x16){};
        for (int kt = 0; kt < 8; ++kt) flash_tile(st, qg, Kb + (size_t)(j * 256 + kt * 32) * 2048, Vb + j * 256 + kt * 32, false, n, hi);
        if (valid) { const float il = 1.0f / st.l; LAS bf16* po = partO + (ql * 3 + slot) * 64 + 4 * hi;
#pragma unroll
            for (int g4 = 0; g4 < 4; ++g4) {
                *(LAS unsigned long long*)(po + 8 * g4) = (unsigned long long)cvtpk(st.o0[4 * g4] * il, st.o0[4 * g4 + 1] * il) | ((unsigned long long)cvtpk(st.o0[4 * g4 + 2] * il, st.o0[4 * g4 + 3] * il) << 32);
                *(LAS unsigned long long*)(po + 32 + 8 * g4) = (unsigned long long)cvtpk(st.o1[4 * g4] * il, st.o1[4 * g4 + 1] * il) | ((unsigned long long)cvtpk(st.o1[4 * g4 + 2] * il, st.o1[4 * g4 + 3] * il) << 32); }
            if (hi == 0) partL[ql * 4 + slot] = st.m + __builtin_amdgcn_logf(st.l); }
    }
    __syncthreads();
    const int nsel = qb < 3 ? qb : 3;
    const float lse_o = own.m + __builtin_amdgcn_logf(own.l);
    float ls[3]; float mx = lse_o;
#pragma unroll
    for (int t = 0; t < 3; ++t) { ls[t] = t < nsel ? partL[qloc * 4 + t] : -INFINITY; mx = fmaxf(mx, ls[t]); }
    float wo = __builtin_amdgcn_exp2f(lse_o - mx), ws_[3], tot = wo;
#pragma unroll
    for (int t = 0; t < 3; ++t) { ws_[t] = __builtin_amdgcn_exp2f(ls[t] - mx); tot += ws_[t]; }
    const float it = 1.0f / tot; wo = wo * it / own.l;
    bf16* op = O + ((size_t)b * SEQ + qb * 256 + qloc) * 1024 + 512 + h * 64 + 4 * hi;
#pragma unroll
    for (int g4 = 0; g4 < 4; ++g4) {
        float a[4], c4[4];
#pragma unroll
        for (int i = 0; i < 4; ++i) { a[i] = own.o0[4 * g4 + i] * wo; c4[i] = own.o1[4 * g4 + i] * wo; }
#pragma unroll
        for (int t = 0; t < 3; ++t) if (t < nsel) { const float wt = ws_[t] * it; const LAS bf16* po = partO + (qloc * 3 + t) * 64 + 4 * hi;
            const unsigned long long u0 = *(const LAS unsigned long long*)(po + 8 * g4), u1 = *(const LAS unsigned long long*)(po + 32 + 8 * g4);
            a[0] += wt * bflo((unsigned)u0); a[1] += wt * bfhi((unsigned)u0); a[2] += wt * bflo((unsigned)(u0 >> 32)); a[3] += wt * bfhi((unsigned)(u0 >> 32));
            c4[0] += wt * bflo((unsigned)u1); c4[1] += wt * bfhi((unsigned)u1); c4[2] += wt * bflo((unsigned)(u1 >> 32)); c4[3] += wt * bfhi((unsigned)(u1 >> 32)); }
        *(unsigned long long*)(op + 8 * g4) = (unsigned long long)cvtpk(a[0], a[1]) | ((unsigned long long)cvtpk(a[2], a[3]) << 32);
        *(unsigned long long*)(op + 32 + 8 * g4) = (unsigned long long)cvtpk(c4[0], c4[1]) | ((unsigned long long)cvtpk(c4[2], c4[3]) << 32); }
}

__device__ __forceinline__ void attn_phase_v1(const Args& a, LAS unsigned char* lds, int G) {
    const bf16* QK = (const bf16*)(a.ws + WS_QK); const bf16* Vt = (const bf16*)(a.ws + WS_VT); bf16* O = (bf16*)(a.ws + WS_O);
    const float* kpart = (const float*)(a.ws + WS_KPART);
    for (int u = blockIdx.x; u < 256; u += G) {
        int tq = threadIdx.x; asm volatile("" : "+v"(tq));
        { const int bh = u >> 4, b = bh >> 3, h = bh & 7, wv = __builtin_amdgcn_readfirstlane(tq >> 6);
          for (int i = 0; i < 2; ++i) sb_wave(QK, Vt, O, b, h, (u & 15) * 16 + wv * 2 + i, tq & 63); }
        for (int k = 0; k < 2; ++k) { const int uu = k == 0 ? u : 511 - u, bh = uu >> 5, qb = uu & 31;
            moba_unit(QK, Vt, O, kpart, lds, bh >> 3, bh & 7, qb, tq); }
    }
}

#define XB_TMO      128
#define XB_XCNT(j)  (256  + 64 * (j))
#define XB_XSUB(j)  (1280 + 64 * (j))
#define XB_XGEN(j)  (2304 + 64 * (j))
#define XB_TOP      3328
#define XB_TOPGEN   3392
#define XCD_BAR_WORDS 3456
#define XB_SPIN_CAP (1u << 18)

__device__ __forceinline__ unsigned xb_ld(unsigned* p)              { return __hip_atomic_load(p, __ATOMIC_RELAXED, __HIP_MEMORY_SCOPE_AGENT); }
__device__ __forceinline__ unsigned xb_add(unsigned* p, unsigned v) { return __hip_atomic_fetch_add(p, v, __ATOMIC_RELAXED, __HIP_MEMORY_SCOPE_AGENT); }
__device__ __forceinline__ unsigned xb_xcc_id() { return (unsigned)__builtin_amdgcn_s_getreg((3 << 11) | 20) & 0xFu; }
#define XB_SPIN(cond, bar) do { unsigned _sp = 0; while (cond) { __builtin_amdgcn_s_sleep(1); \
    if ((++_sp & 255u) == 0u) { if (xb_ld(&(bar)[XB_TMO])) break; if (_sp > XB_SPIN_CAP) { atomicAdd(&(bar)[XB_TMO], 1u); break; } } } } while (0)

struct XcdBarrier {
    unsigned* bar; unsigned x;
    volatile LAS unsigned* st;
};

__device__ __forceinline__ XcdBarrier xcd_barrier_post(unsigned* bar, volatile LAS unsigned* st) {
    XcdBarrier b; b.bar = bar; b.x = xb_xcc_id(); b.st = st;
    if (threadIdx.x == 0) (void)xb_add(&bar[XB_XCNT(b.x)], 1u);
    return b;
}
__device__ __forceinline__ void xcd_barrier_complete(unsigned* bar, unsigned x, unsigned& nloc, unsigned& nx) {
    const unsigned G = gridDim.x * gridDim.y * gridDim.z;
    unsigned sum, cnt, mine, sp = 0u;
    for (;;) {
        sum = 0u; cnt = 0u; mine = 0u;
#pragma unroll
        for (unsigned j = 0; j < 16; ++j) { const unsigned c = xb_ld(&bar[XB_XCNT(j)]); sum += c; cnt += (c > 0u) ? 1u : 0u; mine = (j == x) ? c : mine; }
        if (sum == G) break;
        __builtin_amdgcn_s_sleep(1);
        if ((++sp & 255u) == 0u) { if (xb_ld(&bar[XB_TMO])) break; if (sp > XB_SPIN_CAP) { atomicAdd(&bar[XB_TMO], 1u); break; } }
    }
    nloc = mine > 0u ? mine : 1u; nx = cnt > 0u ? cnt : 1u;
}

__device__ __forceinline__ void xcd_barrier(const XcdBarrier& b) {
    asm volatile("s_waitcnt vmcnt(0)" ::: "memory");
    __syncthreads();
    if (threadIdx.x == 0) {
        unsigned* bar = b.bar;
        __builtin_amdgcn_s_waitcnt(0);
        unsigned nloc = b.st[0], nx = b.st[1];
        if (nloc == 0u) { xcd_barrier_complete(bar, b.x, nloc, nx); b.st[0] = nloc; b.st[1] = nx; }
        const unsigned old = xb_add(&bar[XB_XSUB(b.x)], 1u);
        const unsigned gen = old / nloc;
        if (old + 1u == (gen + 1u) * nloc) {
            __builtin_amdgcn_fence(__ATOMIC_RELEASE, "agent");
            asm volatile("s_waitcnt vmcnt(0)" ::: "memory");
            const unsigned og = xb_add(&bar[XB_TOP], 1u);
            const unsigned tg = og / nx;
            if (og + 1u == (tg + 1u) * nx) xb_add(&bar[XB_TOPGEN], 1u);
            else XB_SPIN(xb_ld(&bar[XB_TOPGEN]) == tg, bar);
            __builtin_amdgcn_fence(__ATOMIC_ACQUIRE, "agent");
            xb_add(&bar[XB_XGEN(b.x)], 1u);
            asm volatile("s_waitcnt vmcnt(0)" ::: "memory");
        } else {
            XB_SPIN(xb_ld(&bar[XB_XGEN(b.x)]) == gen, bar);
            __builtin_amdgcn_fence(__ATOMIC_ACQUIRE, "agent");
            asm volatile("s_waitcnt vmcnt(0)" ::: "memory");
        }
    }
    __syncthreads();
}

#ifndef PROBE_REP
#define PROBE_REP 0
#endif
#define REP(k) for (int rep_ = 0; rep_ < (((PROBE_REP) >> (k)) & 1) + 1; ++rep_)
__global__ void __launch_bounds__(NTHREADS, 2) fwd_megakernel(Args a) {
    extern __shared__ __attribute__((aligned(16))) unsigned char lds_raw[];
    LAS unsigned char* lds = (LAS unsigned char*)lds_raw;
    cg::grid_group grid = cg::this_grid();
    if (gridDim.x == 0x7fffffffu) grid.sync();
    const int tid = threadIdx.x, lane = tid & 63, wave = __builtin_amdgcn_readfirstlane(tid >> 6);
    const int G = gridDim.x, gw = blockIdx.x * NWAVES + wave, NGW = G * NWAVES;
    unsigned char* ws = a.ws;
    bf16* XN = (bf16*)(ws + WS_XN); bf16* QK = (bf16*)(ws + WS_QK); bf16* Gt = (bf16*)(ws + WS_G); bf16* Vt = (bf16*)(ws + WS_VT); bf16* O = (bf16*)(ws + WS_O);
    bf16* MG = (bf16*)(ws + WS_MG); bf16* H = (bf16*)(ws + WS_H); float* Y = (float*)(ws + WS_Y); float* Y2 = (float*)(ws + WS_Y2);
    float* rope = (float*)(ws + WS_ROPE); float* kpart = (float*)(ws + WS_KPART);

    { volatile LAS unsigned* st = (volatile LAS unsigned*)(lds + RING_BYTES); if (tid < 4) st[tid] = 0u; }
    __syncthreads();
    (void)xcd_barrier_post((unsigned*)(ws + WS_BAR), (volatile LAS unsigned*)(lds + RING_BYTES));
#define GRID_BAR() do { XcdBarrier b_; b_.bar = (unsigned*)(a.ws + WS_BAR); b_.x = xb_xcc_id(); b_.st = (volatile LAS unsigned*)(lds + RING_BYTES); xcd_barrier(b_); } while (0)
    REP(0) prologue(a, lds, gw, NGW, wave, lane);
    GRID_BAR();

    for (int l = 0; l < DEPTH; ++l) {
        const unsigned char* wl = ws + WS_W + (size_t)l * W_LAYER;
        const float* Xres = l == 0 ? a.in[0] : a.out;
        REP(1) { pg8::Gemm g{XN, (const bf16*)(wl + WO_MAIN), M, 4096, 1024}; pg8::StaticOrder S; S.init(M, 4096, G, (int)blockIdx.x);
          pg8::EpiInProj E{QK, Gt, rope, kpart};
          pg8::gemm_phase<pg8::EpiInProj, true>(lds, g, S, E); }
        REP(1) { pg8::Gemm g{(const bf16*)(wl + WO_VT), XN, 1024, M, 1024}; pg8::StaticOrder S; S.init(1024, M, G, (int)blockIdx.x);
          pg8::EpiBf16 E{Vt, M};
          pg8::gemm_phase<pg8::EpiBf16, true>(lds, g, S, E); }
        GRID_BAR();
        REP(2) attn_phase_v1(a, lds, G);
        GRID_BAR();
        REP(3) { pg8::Gemm g{O, (const bf16*)(wl + WO_BR), M, 1024, 1024}; pg8::StaticOrder S; S.init(M, 1024, G, (int)blockIdx.x);
          pg8::EpiMerged E{Gt, MG};
          pg8::gemm_phase<pg8::EpiMerged, false>(lds, g, S, E); }
        GRID_BAR();
        REP(4) { pg8::Gemm g{MG, (const bf16*)(wl + WO_OUT), M, 1024, 1024}; pg8::StaticOrder S; S.init(M, 1024, G, (int)blockIdx.x);
          pg8::EpiResid E{Xres, Y, ALPHA};
          pg8::gemm_phase<pg8::EpiResid, false>(lds, g, S, E); }
        GRID_BAR();
        REP(5) ln_phase(Y, a.in[5] + (size_t)l * D, a.in[6] + (size_t)l * D, a.out, XN, gw, NGW, lane);
        GRID_BAR();
        REP(6) { pg8::Gemm g{XN, (const bf16*)(wl + WO_GU), M, 2 * DFF, 1024}; pg8::StaticOrder S; S.init(M, 2 * DFF, G, (int)blockIdx.x);
          pg8::EpiSwiglu E{H};
          pg8::gemm_phase<pg8::EpiSwiglu, true>(lds, g, S, E); }
        GRID_BAR();
        REP(7) { pg8::Gemm g{H, (const bf16*)(wl + WO_DN), M, 1024, DFF}; pg8::StaticOrder S; S.init(M, 1024, G, (int)blockIdx.x);
          pg8::EpiResid E{a.out, Y2, ALPHA};
          pg8::gemm_phase<pg8::EpiResid, false>(lds, g, S, E); }
        GRID_BAR();
        REP(8) ln_phase(Y2, a.in[10] + (size_t)l * D, a.in[11] + (size_t)l * D, a.out, XN, gw, NGW, lane);
        if (l + 1 < DEPTH) GRID_BAR();
        if ((PROBE_REP >> 9) & 1) for (int k = 0; k < 8; ++k) GRID_BAR();
    }
}

extern "C" void kernel_launch(void* const* d_in, const int* in_sizes, int n_in, void* d_out, int out_size, void* d_ws, size_t ws_size, hipStream_t stream) {
    static int grid = 0;
    if (grid == 0) {
        if (n_in != 12 || in_sizes[0] != M * D || out_size != M * D || ws_size < WS_END) { fprintf(stderr, "kernel_launch: unexpected problem shape (n_in %d, ws %zu); nothing launched\n", n_in, ws_size); grid = -1; return; }
        int dev = 0, cus = 0, per_cu = 0;
        if (hipGetDevice(&dev) != hipSuccess || hipDeviceGetAttribute(&cus, hipDeviceAttributeMultiprocessorCount, dev) != hipSuccess) { grid = -1; return; }
        if (hipFuncSetAttribute((const void*)fwd_megakernel, hipFuncAttributeMaxDynamicSharedMemorySize, LDS_BYTES) != hipSuccess) { fprintf(stderr, "kernel_launch: hipFuncSetAttribute failed\n"); grid = -1; return; }
        if (hipOccupancyMaxActiveBlocksPerMultiprocessor(&per_cu, (const void*)fwd_megakernel, NTHREADS, LDS_BYTES) != hipSuccess || per_cu < 1) per_cu = 1;
        (void)hipGetLastError();
        grid = cus;
        (void)per_cu;
    }
    if (grid < 0) return;
    if (hipMemsetAsync((char*)d_ws + WS_BAR, 0, BAR_ZERO_BYTES, stream) != hipSuccess) { fprintf(stderr, "kernel_launch: memset of the barrier words failed\n"); return; }
    Args a{};
    for (int i = 0; i < 12; ++i) a.in[i] = (const float*)d_in[i];
    a.out = (float*)d_out; a.ws = (unsigned char*)d_ws;
    void* args[] = {&a};
    hipError_t e = hipLaunchCooperativeKernel((const void*)fwd_megakernel, dim3(grid), dim3(NTHREADS), args, LDS_BYTES, stream);
    if (e != hipSuccess) fprintf(stderr, "cooperative launch failed: %s (grid %d)\n", hipGetErrorString(e), grid);
}
```

```cpp
#include <hip/hip_runtime.h>
#include <hip/hip_cooperative_groups.h>
#include <cstdio>
#include <cstdint>
namespace cg = cooperative_groups;

namespace pg8 {
#define PG8_LAS __attribute__((address_space(3)))
typedef unsigned short bf16_t;
typedef short bf16x8 __attribute__((ext_vector_type(8)));
typedef float f32x4 __attribute__((ext_vector_type(4)));
typedef float f32x2 __attribute__((ext_vector_type(2)));
typedef unsigned u32x4 __attribute__((ext_vector_type(4)));
constexpr int BM = 256, BK = 64, HALF = 128, HTB = HALF * BK * 2, STAGE_BYTES = 8 * HTB, NXCD = 8, WGM = 8;

__host__ __device__ __forceinline__ int lds_byte(int r, int c) { const int st = (r >> 4) * 2 + (c >> 5), rr = r & 15, cc = c & 31, ob = rr * 64 + cc * 2; return st * 1024 + (ob ^ (((ob >> 9) & 1) << 5)); }
__host__ __device__ __forceinline__ void stage_rc(int b, int& R, int& C) { const int st = b / 1024, sb = b % 1024, swz = sb ^ (((sb >> 9) & 1) << 5); R = (st >> 1) * 16 + swz / 64; C = (st & 1) * 32 + (swz % 64) / 2; }
__host__ __device__ __forceinline__ int perm32(int rho) { const int n = rho >> 4, i = rho & 15; return 8 * (i >> 2) + 4 * n + (i & 3); }

struct Unit { int pm, pn; };
struct Gemm { const bf16_t* A; const bf16_t* Bt; int M, N, K; };

struct StaticOrder {
    int nM, nN, nwg, G, c;
    __host__ __device__ void init(int M, int N, int G_, int c_) { nM = M / BM; nN = N / BM; nwg = nM * nN; G = G_; c = c_; }
    __host__ __device__ bool next(int i, Unit& u) const {
        const long L = (long)i * G + c; if (L >= nwg) return false;
        int wgid = (int)L; { const int q = nwg / NXCD, r = nwg % NXCD, xcd = wgid % NXCD, off = wgid / NXCD; wgid = (xcd < r ? xcd * (q + 1) : r * (q + 1) + (xcd - r) * q) + off; }
        const int nig = WGM * nN, gid = wgid / nig, fm = gid * WGM, gsz = (nM - fm) < WGM ? (nM - fm) : WGM;
        u.pm = fm + ((wgid % nig) % gsz); u.pn = (wgid % nig) / gsz; return true;
    }
};

typedef __bf16 bf16x2_t __attribute__((ext_vector_type(2)));
__device__ __forceinline__ unsigned cvt_pk_bf16(float lo, float hi) { f32x2 v = {lo, hi}; bf16x2_t b = __builtin_convertvector(v, bf16x2_t); return __builtin_bit_cast(unsigned, b); }
__device__ __forceinline__ float bf_lo(unsigned w) { return __uint_as_float(w << 16); }
__device__ __forceinline__ float bf_hi(unsigned w) { return __uint_as_float(w & 0xffff0000u); }
__device__ __forceinline__ float sigmoidf_(float x) { return 1.0f / (1.0f + __expf(-x)); }

typedef f32x4 Acc[2][2][4][2];

struct EpiVt {
    static constexpr bool PERM = true, MID = false;
    bf16_t* Vf;
    __device__ __forceinline__ void mid(Acc&, const Unit&, int, int, int, int) const {}
    __device__ __forceinline__ void operator()(Acc& acc, const Unit& u, int wr, int wc, int fr, int fq) const {
        const int row0 = u.pm * BM + wr * 64 + fr, col0 = u.pn * BM + wc * 32 + 8 * fq;
#pragma unroll
        for (int ai = 0; ai < 2; ++ai)
#pragma unroll
            for (int m = 0; m < 4; ++m) { const int r = row0 + ai * HALF + m * 16, vh = r >> 6, d = r & 63;
#pragma unroll
                for (int bj = 0; bj < 2; ++bj) { const int t = col0 + bj * HALF, b = t >> 13, s = t & 8191;
                    const size_t blk = ((size_t)((vh >> 3) * 16 + b * 8 + (vh & 7)) * 256 + (s >> 5)) * 2048;
                    const int off = (d >> 5) * 1024 + ((s >> 4) & 1) * 512 + ((s >> 3) & 1) * 256 + (d & 31) * 8;
                    const f32x4 v0 = acc[ai][bj][m][0], v1 = acc[ai][bj][m][1];
                    u32x4 w; w.x = cvt_pk_bf16(v0[0], v0[1]); w.y = cvt_pk_bf16(v0[2], v0[3]); w.z = cvt_pk_bf16(v1[0], v1[1]); w.w = cvt_pk_bf16(v1[2], v1[3]);
                    *(u32x4*)(Vf + blk + off) = w; } }
    }
};

struct EpiInProj {
    static constexpr bool PERM = true, MID = false;
    bf16_t* Q; bf16_t* Kf; bf16_t* G; const float* rope; float* kpart;
    __device__ __forceinline__ void mid(Acc&, const Unit&, int, int, int, int) const {}
    __device__ __forceinline__ void operator()(Acc& acc, const Unit& u, int wr, int wc, int fr, int fq) const {
        const int pn = u.pn, seg = pn >> 1;
        const int row0 = u.pm * BM + wr * 64 + fr;
        const bool isk = pn < 8 && (seg & 1);
        bf16_t* base = pn < 8 ? Q : G; const int ld = pn < 8 ? 1024 : 2048; const int colt = pn < 8 ? (seg >> 1) * 512 + (pn & 1) * BM : (pn - 8) * BM;
        const int col0 = colt + wc * 32 + 8 * fq;
        const float sc = (pn < 8 && (seg == 0 || seg == 2)) ? 0.125f : 1.0f;
        const bool do_rope = pn >= 4 && pn < 8 && (wc & 1) == 0;
        const bool do_sum = pn >= 6 && pn < 8;
        f32x4 cs_[2][2];
#pragma unroll
        for (int bj = 0; bj < 2; ++bj)
#pragma unroll
            for (int n = 0; n < 2; ++n) cs_[bj][n] = (f32x4){0.f, 0.f, 0.f, 0.f};
#pragma unroll
        for (int ai = 0; ai < 2; ++ai)
#pragma unroll
            for (int m = 0; m < 4; ++m) { const int row = row0 + ai * HALF + m * 16;
                if (do_rope) { const f32x4* cs = (const f32x4*)(rope + (size_t)(row & 8191) * 16);
                    const f32x4 c0 = cs[0], c1 = cs[1], c2 = cs[2], c3 = cs[3];
                    const f32x4 cosA = {c0[0], c0[2], c1[0], c1[2]}, cosB = {c2[0], c2[2], c3[0], c3[2]}, sinA = {c0[1], c0[3], c1[1], c1[3]}, sinB = {c2[1], c2[3], c3[1], c3[3]};
#pragma unroll
                    for (int bj = 0; bj < 2; ++bj)
#pragma unroll
                        for (int n = 0; n < 2; ++n) { const f32x4 v = acc[ai][bj][m][n]; f32x4 p;
#pragma unroll
                            for (int i = 0; i < 4; ++i) p[i] = __shfl_xor(v[i], 16);
                            const f32x4 c = n == 0 ? cosA : cosB, sn = n == 0 ? sinA : sinB;
                            const f32x4 r = fq == 0 ? v * c - p * sn : v * c + p * sn;
                            if (fq < 2) acc[ai][bj][m][n] = r; } }
                bf16_t* rowp = base + (size_t)row * ld + col0;
                const int s_ = row & 8191, p_ = (s_ & 19) | ((s_ & 4) << 1) | ((s_ & 8) >> 1);
#pragma unroll
                for (int bj = 0; bj < 2; ++bj) { cs_[bj][0] += acc[ai][bj][m][0]; cs_[bj][1] += acc[ai][bj][m][1];
                    const f32x4 v0 = acc[ai][bj][m][0] * sc, v1 = acc[ai][bj][m][1] * sc;
                    u32x4 w; w.x = cvt_pk_bf16(v0[0], v0[1]); w.y = cvt_pk_bf16(v0[2], v0[3]); w.z = cvt_pk_bf16(v1[0], v1[1]); w.w = cvt_pk_bf16(v1[2], v1[3]);
                    if (isk) { const int ck = (pn & 1) * BM + bj * HALF + wc * 32 + 8 * fq, hh = ck >> 6, d = ck & 63;
                        const size_t blk = ((size_t)((seg >> 1) * 16 + (row >> 13) * 8 + hh) * 256 + (s_ >> 5)) * 2048;
                        *(u32x4*)(Kf + blk + (d >> 4) * 512 + ((d >> 3) & 1) * 256 + p_ * 8) = w; }
                    else *(u32x4*)(rowp + bj * HALF) = w; }
                asm volatile("" ::: "memory"); }
        if (do_sum) {
#pragma unroll
            for (int bj = 0; bj < 2; ++bj)
#pragma unroll
                for (int n = 0; n < 2; ++n) { f32x4 s = cs_[bj][n];
#pragma unroll
                    for (int i = 0; i < 4; ++i) { float t = s[i]; t += __shfl_xor(t, 1); t += __shfl_xor(t, 2); t += __shfl_xor(t, 4); t += __shfl_xor(t, 8); s[i] = t; }
                    if (fr == 0) *(f32x4*)(kpart + ((size_t)u.pm * 2 + wr) * 512 + (pn - 6) * BM + bj * HALF + wc * 32 + 8 * fq + 4 * n) = s; }
        }
    }
};

struct EpiMerged {
    static constexpr bool PERM = true, MID = true;
    const bf16_t* G; bf16_t* O;
    __device__ __forceinline__ void mid(Acc& acc, const Unit& u, int wr, int wc, int fr_, int fq) const {
        int fr = fr_; asm volatile("" : "+v"(fr));
        const int row0 = u.pm * BM + wr * 64 + fr, col0 = u.pn * BM + wc * 32 + 8 * fq;
#pragma unroll
        for (int ai = 0; ai < 2; ++ai)
#pragma unroll
            for (int m = 0; m < 4; ++m) { const bf16_t* gp = G + (size_t)(row0 + ai * HALF + m * 16) * 2048 + col0;
#pragma unroll
                for (int bj = 0; bj < 2; ++bj) { const u32x4 a = *(const u32x4*)(gp + bj * HALF), b = *(const u32x4*)(gp + 1024 + bj * HALF);
#pragma unroll
                    for (int j = 0; j < 4; ++j) { const float a0 = bf_lo(a[j]), a1 = bf_hi(a[j]), b0 = fmaxf(bf_lo(b[j]), -60.f), b1 = fmaxf(bf_hi(b[j]), -60.f);
                        const float r0 = sigmoidf_(a0) * (1.0f + __expf(-b0)), r1 = sigmoidf_(a1) * (1.0f + __expf(-b1));
                        acc[ai][bj][m][j >> 1][(j & 1) * 2] *= r0; acc[ai][bj][m][j >> 1][(j & 1) * 2 + 1] *= r1; } }
                asm volatile("" ::: "memory"); }
    }
    __device__ __forceinline__ void operator()(Acc& acc, const Unit& u, int wr, int wc, int fr, int fq) const {
        const int row0 = u.pm * BM + wr * 64 + fr, col0 = u.pn * BM + wc * 32 + 8 * fq;
#pragma unroll
        for (int ai = 0; ai < 2; ++ai)
#pragma unroll
            for (int m = 0; m < 4; ++m) { const size_t r = (size_t)(row0 + ai * HALF + m * 16);
#pragma unroll
                for (int bj = 0; bj < 2; ++bj) { const u32x4 b = *(const u32x4*)(G + r * 2048 + 1024 + col0 + bj * HALF);
                    float o[8];
#pragma unroll
                    for (int j = 0; j < 4; ++j) { const float b0 = fmaxf(bf_lo(b[j]), -60.f), b1 = fmaxf(bf_hi(b[j]), -60.f);
                        o[2 * j] = acc[ai][bj][m][j >> 1][(j & 1) * 2] * sigmoidf_(b0); o[2 * j + 1] = acc[ai][bj][m][j >> 1][(j & 1) * 2 + 1] * sigmoidf_(b1); }
                    u32x4 w; w.x = cvt_pk_bf16(o[0], o[1]); w.y = cvt_pk_bf16(o[2], o[3]); w.z = cvt_pk_bf16(o[4], o[5]); w.w = cvt_pk_bf16(o[6], o[7]);
                    *(u32x4*)(O + r * 1024 + col0 + bj * HALF) = w; }
                asm volatile("" ::: "memory"); }
    }
};

struct EpiResid {
    static constexpr bool PERM = false, MID = false;
    const float* X; float* Y; float alpha;
    __device__ __forceinline__ void mid(Acc&, const Unit&, int, int, int, int) const {}
    __device__ __forceinline__ void operator()(Acc& acc, const Unit& u, int wr, int wc, int fr, int fq) const {
        const int row0 = u.pm * BM + wr * 64 + fr, col0 = u.pn * BM + wc * 32 + 4 * fq;
#pragma unroll
        for (int ai = 0; ai < 2; ++ai)
#pragma unroll
            for (int m = 0; m < 4; ++m) { const size_t off = (size_t)(row0 + ai * HALF + m * 16) * 1024 + col0;
#pragma unroll
                for (int bj = 0; bj < 2; ++bj)
#pragma unroll
                    for (int n = 0; n < 2; ++n) { const f32x4 x = *(const f32x4*)(X + off + bj * HALF + n * 16);
                        *(f32x4*)(Y + off + bj * HALF + n * 16) = x * alpha + acc[ai][bj][m][n]; } }
    }
};

struct EpiSwiglu {
    static constexpr bool PERM = true, MID = false;
    bf16_t* H;
    __device__ __forceinline__ void mid(Acc&, const Unit&, int, int, int, int) const {}
    __device__ __forceinline__ void operator()(Acc& acc, const Unit& u, int wr, int wc, int fr, int fq) const {
        const int row0 = u.pm * BM + wr * 64 + fr, col0 = u.pn * HALF + wc * 32 + 8 * fq;
#pragma unroll
        for (int ai = 0; ai < 2; ++ai)
#pragma unroll
            for (int m = 0; m < 4; ++m) { float o[8];
#pragma unroll
                for (int n = 0; n < 2; ++n)
#pragma unroll
                    for (int i = 0; i < 4; ++i) { const float g = acc[ai][0][m][n][i], up = acc[ai][1][m][n][i]; o[4 * n + i] = g * sigmoidf_(g) * up; }
                u32x4 w; w.x = cvt_pk_bf16(o[0], o[1]); w.y = cvt_pk_bf16(o[2], o[3]); w.z = cvt_pk_bf16(o[4], o[5]); w.w = cvt_pk_bf16(o[6], o[7]);
                *(u32x4*)(H + (size_t)(row0 + ai * HALF + m * 16) * 2816 + col0) = w; }
    }
};

template <class Epi, bool ALIGN_EPI>
__device__ __forceinline__ void gemm_phase(PG8_LAS unsigned char* lds, const Gemm g, const StaticOrder& S, const Epi& E) {
    int tid_ = threadIdx.x; asm volatile("" : "+v"(tid_));
    const int tid = tid_, wid = __builtin_amdgcn_readfirstlane(tid >> 6), lane = tid & 63, wr = wid >> 2, wc = wid & 3, fr = lane & 15, fq = lane >> 4;
    const int K = g.K, nt = K / BK;
    unsigned voffA[2], voffB[2];
#pragma unroll
    for (int i = 0; i < 2; ++i) { int R, C; stage_rc(tid * 16 + i * 8192, R, C); const int Rb = Epi::PERM ? ((R & ~31) + perm32(R & 31)) : R;
        voffA[i] = (unsigned)(R * K + C) * 2u; voffB[i] = (unsigned)(Rb * K + C) * 2u; }
    const size_t kstep = (size_t)(BK * 2);
    const size_t hstep = (size_t)HALF * K * 2;
    const size_t tstep = 2 * hstep;
    const unsigned ldsw = (unsigned)wid * 1024u;
    const int aoff = lds_byte(wr * 64 + fr, fq * 8), boff = lds_byte(wc * 32 + fr, fq * 8);
#define PG8_SA(b, h) (((b) * 2 + (h)) * HTB)
#define PG8_SB(b, h) ((4 + (b) * 2 + (h)) * HTB)
#define PG8_STAGE(bufoff, gbase, voff) do { _Pragma("unroll") for (int _i = 0; _i < 2; ++_i) \
        __builtin_amdgcn_global_load_lds((const unsigned*)((const char*)(gbase) + (voff)[_i]), (PG8_LAS unsigned*)(lds + (bufoff) + ldsw + _i * 8192), 16, 0, 0); } while (0)
#define PG8_LDA(dst, b, h) do { _Pragma("unroll") for (int m = 0; m < 4; ++m) _Pragma("unroll") for (int k = 0; k < 2; ++k) dst[m][k] = *(const PG8_LAS bf16x8*)(lds + PG8_SA(b, h) + aoff + m * 2048 + k * 1024); } while (0)
#define PG8_LDB(dst, b, h) do { _Pragma("unroll") for (int n = 0; n < 2; ++n) _Pragma("unroll") for (int k = 0; k < 2; ++k) dst[n][k] = *(const PG8_LAS bf16x8*)(lds + PG8_SB(b, h) + boff + n * 2048 + k * 1024); } while (0)
#define PG8_MMA(ai, bj, At, Bt) do { __builtin_amdgcn_s_setprio(1); _Pragma("unroll") for (int m = 0; m < 4; ++m) _Pragma("unroll") for (int n = 0; n < 2; ++n) _Pragma("unroll") for (int k = 0; k < 2; ++k) \
        acc[ai][bj][m][n] = __builtin_amdgcn_mfma_f32_16x16x32_bf16(Bt[n][k], At[m][k], acc[ai][bj][m][n], 0, 0, 0); __builtin_amdgcn_s_setprio(0); } while (0)
#define PG8_WAIT_V(n) asm volatile("s_waitcnt vmcnt(" #n ")" ::: "memory")
#define PG8_WAIT_L(n) asm volatile("s_waitcnt lgkmcnt(" #n ")" ::: "memory")
#define PG8_BAR __builtin_amdgcn_s_barrier()
#define PG8_SCHED __builtin_amdgcn_sched_barrier(0)
    Unit cur, nxt; int ui = 0;
    if (!S.next(0, cur)) return;
    Acc acc;
#pragma unroll
    for (int a = 0; a < 2; ++a)
#pragma unroll
        for (int b = 0; b < 2; ++b)
#pragma unroll
            for (int m = 0; m < 4; ++m)
#pragma unroll
                for (int n = 0; n < 2; ++n) acc[a][b][m][n] = (f32x4){0.f, 0.f, 0.f, 0.f};
    bf16x8 At[4][2], B0[2][2], B1[2][2];
    const char* cA = (const char*)g.A + (size_t)cur.pm * tstep; const char* cB = (const char*)g.Bt + (size_t)cur.pn * tstep;
    PG8_STAGE(PG8_SB(0, 0), cB, voffB); PG8_STAGE(PG8_SB(0, 1), cB + hstep, voffB); PG8_STAGE(PG8_SA(0, 0), cA, voffA); PG8_STAGE(PG8_SA(0, 1), cA + hstep, voffA);
    if (wr == 1) PG8_BAR;
    PG8_WAIT_V(2); PG8_BAR;
    PG8_STAGE(PG8_SB(1, 0), cB + kstep, voffB); PG8_STAGE(PG8_SA(1, 0), cA + kstep, voffA); PG8_STAGE(PG8_SB(1, 1), cB + hstep + kstep, voffB);
    PG8_WAIT_V(6); PG8_BAR;
    for (;;) {
        const bool has_next = S.next(ui + 1, nxt);
        const char* nA = has_next ? (const char*)g.A + (size_t)nxt.pm * tstep : cA; const char* nB = has_next ? (const char*)g.Bt + (size_t)nxt.pn * tstep : cB;
        for (int t = 0; t < nt; t += 2) {
            if constexpr (Epi::MID) { if (t == nt / 2) E.mid(acc, cur, wr, wc, fr, fq); }
            const bool last = (t == nt - 2);
            const char* a1 = cA + (size_t)(t + 1) * kstep;
            const char* a2 = last ? nA : cA + (size_t)(t + 2) * kstep; const char* b2 = last ? nB : cB + (size_t)(t + 2) * kstep;
            const char* a3 = a2 + kstep; const char* b3 = b2 + kstep;
            PG8_LDB(B0, 0, 0); PG8_LDB(B1, 0, 1); PG8_SCHED; PG8_LDA(At, 0, 0); PG8_STAGE(PG8_SA(1, 1), a1 + hstep, voffA);
            PG8_WAIT_V(8); PG8_WAIT_L(0); PG8_BAR; PG8_MMA(0, 0, At, B0); PG8_MMA(0, 1, At, B1); PG8_BAR; PG8_SCHED;
            PG8_LDA(At, 0, 1); PG8_STAGE(PG8_SB(0, 0), b2, voffB); PG8_STAGE(PG8_SB(0, 1), b2 + hstep, voffB); PG8_STAGE(PG8_SA(0, 0), a2, voffA);
            PG8_WAIT_V(8); PG8_WAIT_L(0); PG8_BAR; PG8_MMA(1, 0, At, B0); PG8_MMA(1, 1, At, B1); PG8_BAR; PG8_SCHED;
            PG8_LDB(B0, 1, 0); PG8_LDB(B1, 1, 1); PG8_SCHED; PG8_LDA(At, 1, 0); PG8_STAGE(PG8_SA(0, 1), a2 + hstep, voffA);
            PG8_WAIT_V(8); PG8_WAIT_L(0); PG8_BAR; PG8_MMA(0, 0, At, B0); PG8_MMA(0, 1, At, B1); PG8_BAR; PG8_SCHED;
            PG8_LDA(At, 1, 1); PG8_STAGE(PG8_SB(1, 0), b3, voffB); PG8_STAGE(PG8_SB(1, 1), b3 + hstep, voffB); PG8_STAGE(PG8_SA(1, 0), a3, voffA);
            PG8_WAIT_V(8); PG8_WAIT_L(0); PG8_BAR; PG8_MMA(1, 0, At, B0); PG8_MMA(1, 1, At, B1); PG8_BAR; PG8_SCHED;
        }
        if constexpr (ALIGN_EPI) { if (wr == 0) PG8_BAR; }
        E(acc, cur, wr, wc, fr, fq);
        if (!has_next) break;
#pragma unroll
        for (int a = 0; a < 2; ++a)
#pragma unroll
            for (int b = 0; b < 2; ++b)
#pragma unroll
                for (int m = 0; m < 4; ++m)
#pragma unroll
                    for (int n = 0; n < 2; ++n) acc[a][b][m][n] = (f32x4){0.f, 0.f, 0.f, 0.f};
        cur = nxt; cA = nA; cB = nB; ++ui;
        if constexpr (ALIGN_EPI) { if (wr == 1) PG8_BAR; }
    }
    PG8_WAIT_V(0);
    if constexpr (!ALIGN_EPI) { if (wr == 0) PG8_BAR; }
    PG8_BAR;
#undef PG8_SA
#undef PG8_SB
#undef PG8_STAGE
#undef PG8_LDA
#undef PG8_LDB
#undef PG8_MMA
#undef PG8_WAIT_V
#undef PG8_WAIT_L
#undef PG8_BAR
#undef PG8_SCHED
}
}

constexpr int NWAVES = 8, NTHREADS = 512;
constexpr int BATCH = 2, SEQ = 8192, D = 1024, M = BATCH * SEQ, DFF = 2816, DEPTH = 2, HD = 64, NH = 8;
constexpr int IN_COLS = 5120;
constexpr float LN_EPS = 1e-5f;
constexpr float ALPHA = 1.41421356237309515f;

typedef unsigned short bf16;
typedef unsigned v4u __attribute__((ext_vector_type(4)));
typedef float f32x4 __attribute__((ext_vector_type(4)));
#define LAS __attribute__((address_space(3)))

constexpr size_t MiB = 1u << 20;
constexpr size_t WS_W = 0, W_LAYER = 31 * MiB;
constexpr size_t WO_MAIN = 0;
constexpr size_t WO_VT = WO_MAIN + (size_t)4096 * 1024 * 2;
constexpr size_t WO_BR = WO_VT + (size_t)1024 * 1024 * 2;
constexpr size_t WO_OUT = WO_BR + (size_t)1024 * 1024 * 2;
constexpr size_t WO_GU = WO_OUT + (size_t)1024 * 1024 * 2;
constexpr size_t WO_DN = WO_GU + (size_t)5632 * 1024 * 2;
static_assert(WO_DN + (size_t)1024 * 2816 * 2 <= W_LAYER, "weights per layer");
constexpr size_t WS_XN = 62 * MiB;
constexpr size_t WS_O = WS_XN;
constexpr size_t WS_QK = 94 * MiB;
constexpr size_t WS_KF = WS_QK + 32 * MiB;
constexpr size_t WS_MG = WS_QK, WS_H = WS_QK;
constexpr size_t WS_G = 158 * MiB;
constexpr size_t WS_Y = WS_G;
constexpr size_t WS_Y2 = 182 * MiB;
constexpr size_t WS_VT = 222 * MiB;
constexpr size_t WS_ROPE = 254 * MiB;
constexpr size_t WS_KPART = WS_ROPE + 512 * 1024;
constexpr size_t WS_BAR = 255 * MiB, BAR_ZERO_BYTES = 16384;
constexpr size_t WS_END = 256 * MiB;
static_assert(WS_H + (size_t)M * DFF * 2 <= WS_Y2 && WS_Y2 + (size_t)M * D * 4 <= WS_ROPE && WS_KPART + 64 * 2 * 512 * 4 <= WS_END, "d_ws map");

constexpr int RING_BYTES = 131072, LDS_BYTES = 147456;

__device__ __forceinline__ unsigned f2bf(float f) { unsigned u = __builtin_bit_cast(unsigned, f); return (u + 0x7fffu + ((u >> 16) & 1u)) >> 16; }
__device__ __forceinline__ unsigned pk2(float lo, float hi) { return f2bf(lo) | (f2bf(hi) << 16); }
__device__ __forceinline__ float bflo(unsigned w) { return __uint_as_float(w << 16); }
__device__ __forceinline__ float bfhi(unsigned w) { return __uint_as_float(w & 0xffff0000u); }
__device__ __forceinline__ float wave_sum(float v) {
#pragma unroll
    for (int o = 1; o < 64; o <<= 1) v += __shfl_xor(v, o);
    return v;
}

__device__ __forceinline__ void transpose_item(const float* W, int N, int kb, int nb, bf16* dst, int row0, int ld, int col_off, LAS float* scr, int lane) {
    const int k0 = 64 * kb, n0 = 32 * nb;
#pragma unroll 8
    for (int i = 0; i < 32; ++i) { const int kk = 2 * i + (lane >> 5); scr[kk * 33 + (lane & 31)] = W[(size_t)(k0 + kk) * N + n0 + (lane & 31)]; }
    asm volatile("s_waitcnt lgkmcnt(0)" ::: "memory");
    const int c = lane & 7;
#pragma unroll
    for (int j = 0; j < 4; ++j) { const int n = (lane >> 3) + 8 * j; const LAS float* s = scr + (8 * c) * 33 + n;
        v4u o; o.x = pk2(s[0 * 33], s[1 * 33]); o.y = pk2(s[2 * 33], s[3 * 33]); o.z = pk2(s[4 * 33], s[5 * 33]); o.w = pk2(s[6 * 33], s[7 * 33]);
        *(v4u*)(dst + (size_t)(row0 + n) * ld + col_off + k0 + 8 * c) = o; }
    asm volatile("s_waitcnt lgkmcnt(0)" ::: "memory");
}

struct Args { const float* in[12]; float* out; unsigned char* ws; };

__device__ __forceinline__ void prologue(const Args& a, LAS unsigned char* lds, int gw, int NGW, int wave, int lane) {
    LAS float* scr = (LAS float*)(lds + wave * 16384);
    constexpr int I_IN = 16 * 160, I_BR = 8 * 32, I_OUT = 16 * 32, I_G = 16 * 88, I_DN = 44 * 32;
    constexpr int PER_LAYER = I_IN + 2 * I_BR + I_OUT + 2 * I_G + I_DN;
    for (int it = gw; it < DEPTH * PER_LAYER; it += NGW) {
        const int l = it / PER_LAYER; int r = it % PER_LAYER;
        unsigned char* wl = a.ws + WS_W + (size_t)l * W_LAYER;
        if (r < I_IN) { const int kb = r / 160, nb = r % 160, c = nb * 32;
            bf16* dst; int row0;
            if (c < 1024) { dst = (bf16*)(wl + WO_MAIN); row0 = c; }
            else if (c < 1536) { dst = (bf16*)(wl + WO_VT); row0 = c - 1024; }
            else if (c < 2560) { dst = (bf16*)(wl + WO_MAIN); row0 = c - 1536 + 1024; }
            else if (c < 3072) { dst = (bf16*)(wl + WO_VT); row0 = c - 2560 + 512; }
            else { dst = (bf16*)(wl + WO_MAIN); row0 = c - 3072 + 2048; }
            transpose_item(a.in[1] + (size_t)l * 1024 * IN_COLS, IN_COLS, kb, nb, dst, row0, 1024, 0, scr, lane); continue; }
        r -= I_IN;
        if (r < I_BR) { transpose_item(a.in[2] + (size_t)l * 512 * 1024, 1024, r / 32, r % 32, (bf16*)(wl + WO_BR), (r % 32) * 32, 1024, 0, scr, lane); continue; }
        r -= I_BR;
        if (r < I_BR) { transpose_item(a.in[3] + (size_t)l * 512 * 1024, 1024, r / 32, r % 32, (bf16*)(wl + WO_BR), (r % 32) * 32, 1024, 512, scr, lane); continue; }
        r -= I_BR;
        if (r < I_OUT) { transpose_item(a.in[4] + (size_t)l * 1024 * 1024, 1024, r / 32, r % 32, (bf16*)(wl + WO_OUT), (r % 32) * 32, 1024, 0, scr, lane); continue; }
        r -= I_OUT;
        if (r < I_G) { const int nb = r % 88, c = nb * 32; transpose_item(a.in[7] + (size_t)l * 1024 * DFF, DFF, r / 88, nb, (bf16*)(wl + WO_GU), 256 * (c / 128) + (c % 128), 1024, 0, scr, lane); continue; }
        r -= I_G;
        if (r < I_G) { const int nb = r % 88, c = nb * 32; transpose_item(a.in[8] + (size_t)l * 1024 * DFF, DFF, r / 88, nb, (bf16*)(wl + WO_GU), 256 * (c / 128) + 128 + (c % 128), 1024, 0, scr, lane); continue; }
        r -= I_G;
        transpose_item(a.in[9] + (size_t)l * DFF * 1024, 1024, r / 32, r % 32, (bf16*)(wl + WO_DN), (r % 32) * 32, DFF, 0, scr, lane);
    }
    bf16* XN = (bf16*)(a.ws + WS_XN);
    for (int m = gw; m < M; m += NGW) { const f32x4* xr = (const f32x4*)(a.in[0] + (size_t)m * D) + lane; unsigned long long* o8 = (unsigned long long*)(XN + (size_t)m * D) + lane;
#pragma unroll
        for (int j = 0; j < 4; ++j) { const f32x4 v = xr[64 * j]; o8[64 * j] = (unsigned long long)pk2(v.x, v.y) | ((unsigned long long)pk2(v.z, v.w) << 32); } }
    float* rope = (float*)(a.ws + WS_ROPE);
    for (int e = gw * 64 + lane; e < SEQ * 8; e += NGW * 64) { const int pos = e >> 3, i = e & 7;
        const double ang = (double)pos * exp(-(double)i * 0.125 * log(500000.0));
        rope[2 * e] = (float)cos(ang); rope[2 * e + 1] = (float)sin(ang); }
}

__device__ __forceinline__ void ln_phase(const float* Y, const float* gam, const float* bet, float* X, bf16* XN, int gw, int NGW, int lane_) {
    int lane = lane_; asm volatile("" : "+v"(lane));
    for (int m = gw; m < M; m += NGW) {
        const f32x4* yr = (const f32x4*)(Y + (size_t)m * D) + lane;
        f32x4 v[4]; float s = 0.f;
#pragma unroll
        for (int j = 0; j < 4; ++j) { v[j] = yr[64 * j]; s += (v[j].x + v[j].y) + (v[j].z + v[j].w); }
        const float mean = wave_sum(s) * (1.f / D); float s2 = 0.f;
#pragma unroll
        for (int j = 0; j < 4; ++j) { v[j] = v[j] - mean; s2 += (v[j].x * v[j].x + v[j].y * v[j].y) + (v[j].z * v[j].z + v[j].w * v[j].w); }
        const float rstd = 1.f / sqrtf(wave_sum(s2) * (1.f / D) + LN_EPS);
        f32x4* xo = (f32x4*)(X + (size_t)m * D) + lane; unsigned long long* o8 = (unsigned long long*)(XN + (size_t)m * D) + lane;
#pragma unroll
        for (int j = 0; j < 4; ++j) { const f32x4 g = ((const f32x4*)gam)[lane + 64 * j], b = ((const f32x4*)bet)[lane + 64 * j];
            const f32x4 o = v[j] * rstd * g + b; xo[64 * j] = o;
            o8[64 * j] = (unsigned long long)pk2(o.x, o.y) | ((unsigned long long)pk2(o.z, o.w) << 32); }
    }
}

typedef short bf16x8_t __attribute__((ext_vector_type(8)));
typedef float f32x16 __attribute__((ext_vector_type(16)));
__device__ __forceinline__ unsigned cvtpk(float lo, float hi) { return pg8::cvt_pk_bf16(lo, hi); }
__device__ __forceinline__ bf16x8_t pack8(const float* w) { v4u p; p.x = cvtpk(w[0], w[1]); p.y = cvtpk(w[2], w[3]); p.z = cvtpk(w[4], w[5]); p.w = cvtpk(w[6], w[7]); return __builtin_bit_cast(bf16x8_t, p); }
constexpr float SB_STOP = -88.0f;

__device__ __forceinline__ void sb_wave(const bf16* Q, const bf16* Kf, const bf16* Vf, bf16* O, int b, int h, int qt, int lane) {
    const int n = lane & 31, hi = lane >> 5;
    const size_t rowq = (size_t)b * SEQ + qt * 32 + n;
    bf16x8_t qf[4];
#pragma unroll
    for (int d0 = 0; d0 < 4; ++d0) qf[d0] = *(const bf16x8_t*)(Q + rowq * 1024 + h * 64 + 16 * d0 + 8 * hi);
    const bf16* Kb = Kf + (size_t)(b * 8 + h) * 256 * 2048 + lane * 8;
    const bf16* Vb = Vf + (size_t)(b * 8 + h) * 256 * 2048 + lane * 8;
    f32x16 o0 = {}, o1 = {};
    float c = 0.f;
    bf16x8_t kf[4], v00, v01, v10, v11, nk[4], n00, n01, n10, n11;
    { const bf16* kp = Kb + (size_t)qt * 2048; const bf16* vp = Vb + (size_t)qt * 2048;
#pragma unroll
      for (int d0 = 0; d0 < 4; ++d0) kf[d0] = *(const bf16x8_t*)(kp + 512 * d0);
      v00 = *(const bf16x8_t*)(vp); v01 = *(const bf16x8_t*)(vp + 512); v10 = *(const bf16x8_t*)(vp + 1024); v11 = *(const bf16x8_t*)(vp + 1536); }
    for (int kt = qt; kt >= 0; --kt) {
        if (kt > 0) { const bf16* kp = Kb + (size_t)(kt - 1) * 2048; const bf16* vp = Vb + (size_t)(kt - 1) * 2048;
#pragma unroll
            for (int d0 = 0; d0 < 4; ++d0) nk[d0] = *(const bf16x8_t*)(kp + 512 * d0);
            n00 = *(const bf16x8_t*)(vp); n01 = *(const bf16x8_t*)(vp + 512); n10 = *(const bf16x8_t*)(vp + 1024); n11 = *(const bf16x8_t*)(vp + 1536); }
        f32x16 s = {};
#pragma unroll
        for (int d0 = 0; d0 < 4; ++d0) s = __builtin_amdgcn_mfma_f32_32x32x16_bf16(kf[d0], qf[d0], s, 0, 0, 0);
        float lk[16], ls[16];
        const bool diag = (kt == qt);
#pragma unroll
        for (int r = 0; r < 16; ++r) { const float zz = s[r]; const float l1p = __logf(1.0f + __expf(-fabsf(zz)));
            const bool past = !diag || (16 * (r >> 3) + 8 * hi + (r & 7)) < n;
            lk[r] = past ? -(fmaxf(zz, 0.f) + l1p) : 0.f; ls[r] = past ? fminf(zz, 0.f) - l1p : -INFINITY; }
        const float G0 = ((lk[0] + lk[1]) + (lk[2] + lk[3])) + ((lk[4] + lk[5]) + (lk[6] + lk[7])), G1 = ((lk[8] + lk[9]) + (lk[10] + lk[11])) + ((lk[12] + lk[13]) + (lk[14] + lk[15]));
        const float oG0 = __shfl_xor(G0, 32), oG1 = __shfl_xor(G1, 32);
        const float tailA = c + (hi == 0 ? (oG0 + G1) + oG1 : G1 + oG1), tailB = c + (hi == 0 ? oG1 : 0.f);
        float w[16]; float run = 0.f;
#pragma unroll
        for (int r = 7; r >= 0; --r) { w[r] = __expf(ls[r] + (run + tailA)); run += lk[r]; }
        run = 0.f;
#pragma unroll
        for (int r = 15; r >= 8; --r) { w[r] = __expf(ls[r] + (run + tailB)); run += lk[r]; }
        c += (G0 + oG0) + (G1 + oG1);
        const bf16x8_t pa0 = pack8(w), pa1 = pack8(w + 8);
        o0 = __builtin_amdgcn_mfma_f32_32x32x16_bf16(v00, pa0, o0, 0, 0, 0); o0 = __builtin_amdgcn_mfma_f32_32x32x16_bf16(v01, pa1, o0, 0, 0, 0);
        o1 = __builtin_amdgcn_mfma_f32_32x32x16_bf16(v10, pa0, o1, 0, 0, 0); o1 = __builtin_amdgcn_mfma_f32_32x32x16_bf16(v11, pa1, o1, 0, 0, 0);
        if (__all(c < SB_STOP)) break;
#pragma unroll
        for (int d0 = 0; d0 < 4; ++d0) kf[d0] = nk[d0];
        v00 = n00; v01 = n01; v10 = n10; v11 = n11;
    }
    bf16* op = O + rowq * 1024 + h * 64 + 4 * hi;
#pragma unroll
    for (int g4 = 0; g4 < 4; ++g4) {
        unsigned long long a = (unsigned long long)cvtpk(o0[4 * g4], o0[4 * g4 + 1]) | ((unsigned long long)cvtpk(o0[4 * g4 + 2], o0[4 * g4 + 3]) << 32);
        unsigned long long c1 = (unsigned long long)cvtpk(o1[4 * g4], o1[4 * g4 + 1]) | ((unsigned long long)cvtpk(o1[4 * g4 + 2], o1[4 * g4 + 3]) << 32);
        *(unsigned long long*)(op + 8 * g4) = a; *(unsigned long long*)(op + 32 + 8 * g4) = c1; }
}

constexpr float LOG2E = 1.4426950408889634f;
constexpr int ML_KM = 0, ML_CNT = 8192, ML_CTR = ML_CNT + 128, ML_NGRP = ML_CTR + 4, ML_GRP = ML_CNT + 256, ML_LIST = ML_CNT + 1024, ML_PL = ML_LIST + 32 * 256 * 2, ML_PO = ML_PL + 256 * 4 * 4, ML_END = ML_PO + 256 * 3 * 64 * 2;
static_assert(ML_END <= 131072, "MoBA LDS map");
struct Flash { float m, l; f32x16 o0, o1; };
struct KV { bf16x8_t k[4], v00, v01, v10, v11; };
__device__ __forceinline__ void kv_load(KV& t, const bf16* kp, const bf16* vp) {
#pragma unroll
    for (int d0 = 0; d0 < 4; ++d0) t.k[d0] = *(const bf16x8_t*)(kp + 512 * d0);
    t.v00 = *(const bf16x8_t*)(vp); t.v01 = *(const bf16x8_t*)(vp + 512); t.v10 = *(const bf16x8_t*)(vp + 1024); t.v11 = *(const bf16x8_t*)(vp + 1536);
}
__device__ __forceinline__ void flash_tile(Flash& st, const bf16x8_t* qf, const KV& t, bool diag, int n, int hi) {
    f32x16 s = {};
#pragma unroll
    for (int d0 = 0; d0 < 4; ++d0) s = __builtin_amdgcn_mfma_f32_32x32x16_bf16(t.k[d0], qf[d0], s, 0, 0, 0);
    float p[16]; float tmax = -INFINITY;
#pragma unroll
    for (int r = 0; r < 16; ++r) { float v = s[r] * LOG2E; if (diag && (16 * (r >> 3) + 8 * hi + (r & 7)) > n) v = -INFINITY; p[r] = v; tmax = fmaxf(tmax, v); }
    tmax = fmaxf(tmax, __shfl_xor(tmax, 32));
    const float mnew = fmaxf(st.m, tmax), alpha = __builtin_amdgcn_exp2f(st.m - mnew);
    float rs = 0.f;
#pragma unroll
    for (int r = 0; r < 16; ++r) { p[r] = __builtin_amdgcn_exp2f(p[r] - mnew); rs += p[r]; }
    rs += __shfl_xor(rs, 32);
    st.l = st.l * alpha + rs; st.m = mnew;
    st.o0 *= alpha; st.o1 *= alpha;
    const bf16x8_t pa0 = pack8(p), pa1 = pack8(p + 8);
    st.o0 = __builtin_amdgcn_mfma_f32_32x32x16_bf16(t.v00, pa0, st.o0, 0, 0, 0); st.o0 = __builtin_amdgcn_mfma_f32_32x32x16_bf16(t.v01, pa1, st.o0, 0, 0, 0);
    st.o1 = __builtin_amdgcn_mfma_f32_32x32x16_bf16(t.v10, pa0, st.o1, 0, 0, 0); st.o1 = __builtin_amdgcn_mfma_f32_32x32x16_bf16(t.v11, pa1, st.o1, 0, 0, 0);
}
__device__ __forceinline__ void flash_run(Flash& st, const bf16x8_t* qf, const bf16* kp, const bf16* vp, int nt, bool diag_last, int n, int hi) {
    KV cur, nxt; kv_load(cur, kp, vp);
    for (int t = 0; t < nt; ++t) {
        if (t + 1 < nt) kv_load(nxt, kp + (size_t)(t + 1) * 2048, vp + (size_t)(t + 1) * 2048);
        flash_tile(st, qf, cur, diag_last && t == nt - 1, n, hi);
        cur = nxt;
    }
}
__device__ __forceinline__ void split_bf16x8(const LAS float* src, bf16x8_t& hi8, bf16x8_t& lo8) {
    float x[8], lo[8];
#pragma unroll
    for (int i = 0; i < 8; ++i) x[i] = src[i];
    v4u h; h.x = cvtpk(x[0], x[1]); h.y = cvtpk(x[2], x[3]); h.z = cvtpk(x[4], x[5]); h.w = cvtpk(x[6], x[7]);
    lo[0] = x[0] - bflo(h.x); lo[1] = x[1] - bfhi(h.x); lo[2] = x[2] - bflo(h.y); lo[3] = x[3] - bfhi(h.y); lo[4] = x[4] - bflo(h.z); lo[5] = x[5] - bfhi(h.z); lo[6] = x[6] - bflo(h.w); lo[7] = x[7] - bfhi(h.w);
    hi8 = __builtin_bit_cast(bf16x8_t, h); lo8 = pack8(lo);
}

__device__ __forceinline__ void moba_unit(const bf16* Q, const bf16* Kf, const bf16* Vf, bf16* O, const float* kpart, LAS unsigned char* lds, int b, int h, int qb, int tid) {
    const int lane = tid & 63, n = lane & 31, hi = lane >> 5, w = __builtin_amdgcn_readfirstlane(tid >> 6);
    LAS float* kmean = (LAS float*)(lds + ML_KM); LAS unsigned* cnt = (LAS unsigned*)(lds + ML_CNT); LAS unsigned* ctr = (LAS unsigned*)(lds + ML_CTR); LAS unsigned* ngrp = (LAS unsigned*)(lds + ML_NGRP);
    LAS unsigned* grp = (LAS unsigned*)(lds + ML_GRP); LAS unsigned short* list = (LAS unsigned short*)(lds + ML_LIST); LAS float* partL = (LAS float*)(lds + ML_PL); LAS bf16* partO = (LAS bf16*)(lds + ML_PO);
    __syncthreads();
    if (tid < 64) cnt[tid] = 0u;
    for (int e = tid; e < 32 * 64; e += NTHREADS) { const int j = e >> 6, d = e & 63; const float* kp = kpart + ((size_t)(b * 32 + j) * 2) * 512 + h * 64 + d;
        kmean[e] = (kp[0] + kp[512]) * (1.0f / 256.0f); }
    __syncthreads();
    const bf16* Kb = Kf + (size_t)(16 + b * 8 + h) * 256 * 2048 + lane * 8;
    const bf16* Vb = Vf + (size_t)(16 + b * 8 + h) * 256 * 2048 + lane * 8;
    const bf16* Qb = Q + ((size_t)b * SEQ + qb * 256) * 1024 + 512 + h * 64 + 8 * hi;
    const int qloc = w * 32 + n;
    bf16x8_t qf[4];
#pragma unroll
    for (int d0 = 0; d0 < 4; ++d0) qf[d0] = *(const bf16x8_t*)(Qb + (size_t)qloc * 1024 + 16 * d0);
    if (qb > 0) {
        f32x16 g = {};
#pragma unroll
        for (int d0 = 0; d0 < 4; ++d0) { bf16x8_t kh, kl; split_bf16x8(kmean + n * 64 + 16 * d0 + 8 * hi, kh, kl);
            g = __builtin_amdgcn_mfma_f32_32x32x16_bf16(kh, qf[d0], g, 0, 0, 0); g = __builtin_amdgcn_mfma_f32_32x32x16_bf16(kl, qf[d0], g, 0, 0, 0); }
        float gv[16];
#pragma unroll
        for (int r = 0; r < 16; ++r) { const int j = (r & 3) + 8 * (r >> 2) + 4 * hi; gv[r] = j < qb ? g[r] : -INFINITY; }
#pragma unroll
        for (int t = 0; t < 3; ++t) {
            float bv = -INFINITY; int bj = 64;
#pragma unroll
            for (int r = 0; r < 16; ++r) { const int j = (r & 3) + 8 * (r >> 2) + 4 * hi; if (gv[r] > bv) { bv = gv[r]; bj = j; } }
            const float pv = __shfl_xor(bv, 32); const int pj = __shfl_xor(bj, 32);
            if (pv > bv || (pv == bv && pj < bj)) { bv = pv; bj = pj; }
#pragma unroll
            for (int r = 0; r < 16; ++r) { const int j = (r & 3) + 8 * (r >> 2) + 4 * hi; if (j == bj) gv[r] = -INFINITY; }
            if (hi == 0 && bv > -INFINITY) { const unsigned pos = __hip_atomic_fetch_add(cnt + bj, 1u, __ATOMIC_RELAXED, __HIP_MEMORY_SCOPE_WORKGROUP);
                list[bj * 256 + pos] = (unsigned short)(qloc | (t << 8)); }
        }
    }
    __syncthreads();
    if (w == 0) { const unsigned c = n < qb ? cnt[n] : 0u; const int ng = hi == 0 ? (int)((c + 31u) >> 5) : 0;
        int incl = ng;
#pragma unroll
        for (int o = 1; o < 32; o <<= 1) { const int t = __shfl_up(incl, o); if (n >= o) incl += t; }
        const int base = incl - ng;
        if (hi == 0) { for (int k = 0; k < ng; ++k) grp[base + k] = (unsigned)n | ((unsigned)(k * 32) << 8); if (n == 31) ngrp[0] = (unsigned)incl; } }
    Flash own; own.m = -INFINITY; own.l = 0.f; own.o0 = (f32x16){}; own.o1 = (f32x16){};
    flash_run(own, qf, Kb + (size_t)(qb * 8) * 2048, Vb + (size_t)(qb * 8) * 2048, w + 1, true, n, hi);
    __syncthreads();
    const unsigned NG = ngrp[0];
    for (;;) {
        unsigned gi = 0; if (lane == 0) gi = __hip_atomic_fetch_add(ctr, 1u, __ATOMIC_RELAXED, __HIP_MEMORY_SCOPE_WORKGROUP);
        gi = __builtin_amdgcn_readfirstlane(gi);
        if (gi >= NG) break;
        const unsigned ge = grp[gi]; const int j = ge & 255, start = ge >> 8; const int cj = (int)cnt[j];
        const bool valid = start + n < cj;
        const unsigned e = list[j * 256 + (valid ? start + n : start)]; const int ql = e & 255, slot = e >> 8;
        bf16x8_t qg[4];
#pragma unroll
        for (int d0 = 0; d0 < 4; ++d0) qg[d0] = *(const bf16x8_t*)(Qb + (size_t)ql * 1024 + 16 * d0);
        Flash st; st.m = -INFINITY; st.l = 0.f; st.o0 = (f32x16){}; st.o1 = (f32x16){};
        flash_run(st, qg, Kb + (size_t)(j * 8) * 2048, Vb + (size_t)(j * 8) * 2048, 8, false, n, hi);
        if (valid) { const float il = 1.0f / st.l; LAS bf16* po = partO + (ql * 3 + slot) * 64 + 4 * hi;
#pragma unroll
            for (int g4 = 0; g4 < 4; ++g4) {
                *(LAS unsigned long long*)(po + 8 * g4) = (unsigned long long)cvtpk(st.o0[4 * g4] * il, st.o0[4 * g4 + 1] * il) | ((unsigned long long)cvtpk(st.o0[4 * g4 + 2] * il, st.o0[4 * g4 + 3] * il) << 32);
                *(LAS unsigned long long*)(po + 32 + 8 * g4) = (unsigned long long)cvtpk(st.o1[4 * g4] * il, st.o1[4 * g4 + 1] * il) | ((unsigned long long)cvtpk(st.o1[4 * g4 + 2] * il, st.o1[4 * g4 + 3] * il) << 32); }
            if (hi == 0) partL[ql * 4 + slot] = st.m + __builtin_amdgcn_logf(st.l); }
    }
    __syncthreads();
    const int nsel = qb < 3 ? qb : 3;
    const float lse_o = own.m + __builtin_amdgcn_logf(own.l);
    float ls[3]; float mx = lse_o;
#pragma unroll
    for (int t = 0; t < 3; ++t) { ls[t] = t < nsel ? partL[qloc * 4 + t] : -INFINITY; mx = fmaxf(mx, ls[t]); }
    float wo = __builtin_amdgcn_exp2f(lse_o - mx), ws_[3], tot = wo;
#pragma unroll
    for (int t = 0; t < 3; ++t) { ws_[t] = __builtin_amdgcn_exp2f(ls[t] - mx); tot += ws_[t]; }
    const float it = 1.0f / tot; wo = wo * it / own.l;
    bf16* op = O + ((size_t)b * SEQ + qb * 256 + qloc) * 1024 + 512 + h * 64 + 4 * hi;
#pragma unroll
    for (int g4 = 0; g4 < 4; ++g4) {
        float a[4], c4[4];
#pragma unroll
        for (int i = 0; i < 4; ++i) { a[i] = own.o0[4 * g4 + i] * wo; c4[i] = own.o1[4 * g4 + i] * wo; }
#pragma unroll
        for (int t = 0; t < 3; ++t) if (t < nsel) { const float wt = ws_[t] * it; const LAS bf16* po = partO + (qloc * 3 + t) * 64 + 4 * hi;
            const unsigned long long u0 = *(const LAS unsigned long long*)(po + 8 * g4), u1 = *(const LAS unsigned long long*)(po + 32 + 8 * g4);
            a[0] += wt * bflo((unsigned)u0); a[1] += wt * bfhi((unsigned)u0); a[2] += wt * bflo((unsigned)(u0 >> 32)); a[3] += wt * bfhi((unsigned)(u0 >> 32));
            c4[0] += wt * bflo((unsigned)u1); c4[1] += wt * bfhi((unsigned)u1); c4[2] += wt * bflo((unsigned)(u1 >> 32)); c4[3] += wt * bfhi((unsigned)(u1 >> 32)); }
        *(unsigned long long*)(op + 8 * g4) = (unsigned long long)cvtpk(a[0], a[1]) | ((unsigned long long)cvtpk(a[2], a[3]) << 32);
        *(unsigned long long*)(op + 32 + 8 * g4) = (unsigned long long)cvtpk(c4[0], c4[1]) | ((unsigned long long)cvtpk(c4[2], c4[3]) << 32); }
}

__device__ __forceinline__ void attn_phase_v1(const Args& a, LAS unsigned char* lds, int G) {
    const bf16* Q = (const bf16*)(a.ws + WS_QK); const bf16* Kf = (const bf16*)(a.ws + WS_KF); const bf16* Vf = (const bf16*)(a.ws + WS_VT); bf16* O = (bf16*)(a.ws + WS_O);
    const float* kpart = (const float*)(a.ws + WS_KPART);
    for (int u = blockIdx.x; u < 256; u += G) {
        int tq = threadIdx.x; asm volatile("" : "+v"(tq));
        const int xcd = u & 7, slot = u >> 3;
        { const int bh = 2 * xcd + (slot >> 4), wv = __builtin_amdgcn_readfirstlane(tq >> 6);
          for (int i = 0; i < 2; ++i) sb_wave(Q, Kf, Vf, O, bh >> 3, bh & 7, (slot & 15) * 16 + wv * 2 + i, tq & 63); }
        for (int k = 0; k < 2; ++k) { const int bh = 2 * xcd + k, qb = k == 0 ? slot : 31 - slot;
            moba_unit(Q, Kf, Vf, O, kpart, lds, bh >> 3, bh & 7, qb, tq); }
    }
}

#define XB_TMO      128
#define XB_XCNT(j)  (256  + 64 * (j))
#define XB_XSUB(j)  (1280 + 64 * (j))
#define XB_XGEN(j)  (2304 + 64 * (j))
#define XB_TOP      3328
#define XB_TOPGEN   3392
#define XCD_BAR_WORDS 3456
#define XB_SPIN_CAP (1u << 18)

__device__ __forceinline__ unsigned xb_ld(unsigned* p)              { return __hip_atomic_load(p, __ATOMIC_RELAXED, __HIP_MEMORY_SCOPE_AGENT); }
__device__ __forceinline__ unsigned xb_add(unsigned* p, unsigned v) { return __hip_atomic_fetch_add(p, v, __ATOMIC_RELAXED, __HIP_MEMORY_SCOPE_AGENT); }
__device__ __forceinline__ unsigned xb_xcc_id() { return (unsigned)__builtin_amdgcn_s_getreg((3 << 11) | 20) & 0xFu; }
#define XB_SPIN(cond, bar) do { unsigned _sp = 0; while (cond) { __builtin_amdgcn_s_sleep(1); \
    if ((++_sp & 255u) == 0u) { if (xb_ld(&(bar)[XB_TMO])) break; if (_sp > XB_SPIN_CAP) { atomicAdd(&(bar)[XB_TMO], 1u); break; } } } } while (0)

struct XcdBarrier {
    unsigned* bar; unsigned x;
    volatile LAS unsigned* st;
};

__device__ __forceinline__ XcdBarrier xcd_barrier_post(unsigned* bar, volatile LAS unsigned* st) {
    XcdBarrier b; b.bar = bar; b.x = xb_xcc_id(); b.st = st;
    if (threadIdx.x == 0) (void)xb_add(&bar[XB_XCNT(b.x)], 1u);
    return b;
}
__device__ __forceinline__ void xcd_barrier_complete(unsigned* bar, unsigned x, unsigned& nloc, unsigned& nx) {
    const unsigned G = gridDim.x * gridDim.y * gridDim.z;
    unsigned sum, cnt, mine, sp = 0u;
    for (;;) {
        sum = 0u; cnt = 0u; mine = 0u;
#pragma unroll
        for (unsigned j = 0; j < 16; ++j) { const unsigned c = xb_ld(&bar[XB_XCNT(j)]); sum += c; cnt += (c > 0u) ? 1u : 0u; mine = (j == x) ? c : mine; }
        if (sum == G) break;
        __builtin_amdgcn_s_sleep(1);
        if ((++sp & 255u) == 0u) { if (xb_ld(&bar[XB_TMO])) break; if (sp > XB_SPIN_CAP) { atomicAdd(&bar[XB_TMO], 1u); break; } }
    }
    nloc = mine > 0u ? mine : 1u; nx = cnt > 0u ? cnt : 1u;
}

__device__ __forceinline__ void xcd_barrier(const XcdBarrier& b) {
    asm volatile("s_waitcnt vmcnt(0)" ::: "memory");
    __syncthreads();
    if (threadIdx.x == 0) {
        unsigned* bar = b.bar;
        __builtin_amdgcn_s_waitcnt(0);
        unsigned nloc = b.st[0], nx = b.st[1];
        if (nloc == 0u) { xcd_barrier_complete(bar, b.x, nloc, nx); b.st[0] = nloc; b.st[1] = nx; }
        const unsigned old = xb_add(&bar[XB_XSUB(b.x)], 1u);
        const unsigned gen = old / nloc;
        if (old + 1u == (gen + 1u) * nloc) {
            __builtin_amdgcn_fence(__ATOMIC_RELEASE, "agent");
            asm volatile("s_waitcnt vmcnt(0)" ::: "memory");
            const unsigned og = xb_add(&bar[XB_TOP], 1u);
            const unsigned tg = og / nx;
            if (og + 1u == (tg + 1u) * nx) xb_add(&bar[XB_TOPGEN], 1u);
            else XB_SPIN(xb_ld(&bar[XB_TOPGEN]) == tg, bar);
            __builtin_amdgcn_fence(__ATOMIC_ACQUIRE, "agent");
            xb_add(&bar[XB_XGEN(b.x)], 1u);
            asm volatile("s_waitcnt vmcnt(0)" ::: "memory");
        } else {
            XB_SPIN(xb_ld(&bar[XB_XGEN(b.x)]) == gen, bar);
            __builtin_amdgcn_fence(__ATOMIC_ACQUIRE, "agent");
            asm volatile("s_waitcnt vmcnt(0)" ::: "memory");
        }
    }
    __syncthreads();
}

#ifndef PROBE_REP
#define PROBE_REP 0
#endif
#define REP(k) for (int rep_ = 0; rep_ < (((PROBE_REP) >> (k)) & 1) + 1; ++rep_)
__global__ void __launch_bounds__(NTHREADS, 2) fwd_megakernel(Args a) {
    extern __shared__ __attribute__((aligned(16))) unsigned char lds_raw[];
    LAS unsigned char* lds = (LAS unsigned char*)lds_raw;
    cg::grid_group grid = cg::this_grid();
    if (gridDim.x == 0x7fffffffu) grid.sync();
    const int tid = threadIdx.x, lane = tid & 63, wave = __builtin_amdgcn_readfirstlane(tid >> 6);
    const int G = gridDim.x, gw = blockIdx.x * NWAVES + wave, NGW = G * NWAVES;
    unsigned char* ws = a.ws;
    bf16* XN = (bf16*)(ws + WS_XN); bf16* QK = (bf16*)(ws + WS_QK); bf16* Gt = (bf16*)(ws + WS_G); bf16* Vt = (bf16*)(ws + WS_VT); bf16* O = (bf16*)(ws + WS_O);
    bf16* MG = (bf16*)(ws + WS_MG); bf16* H = (bf16*)(ws + WS_H); float* Y = (float*)(ws + WS_Y); float* Y2 = (float*)(ws + WS_Y2);
    float* rope = (float*)(ws + WS_ROPE); float* kpart = (float*)(ws + WS_KPART);

    { volatile LAS unsigned* st = (volatile LAS unsigned*)(lds + RING_BYTES); if (tid < 4) st[tid] = 0u; }
    __syncthreads();
    (void)xcd_barrier_post((unsigned*)(ws + WS_BAR), (volatile LAS unsigned*)(lds + RING_BYTES));
#define GRID_BAR() do { XcdBarrier b_; b_.bar = (unsigned*)(a.ws + WS_BAR); b_.x = xb_xcc_id(); b_.st = (volatile LAS unsigned*)(lds + RING_BYTES); xcd_barrier(b_); } while (0)
    REP(0) prologue(a, lds, gw, NGW, wave, lane);
    GRID_BAR();

    for (int l = 0; l < DEPTH; ++l) {
        const unsigned char* wl = ws + WS_W + (size_t)l * W_LAYER;
        const float* Xres = l == 0 ? a.in[0] : a.out;
        REP(1) { pg8::Gemm g{XN, (const bf16*)(wl + WO_MAIN), M, 4096, 1024}; pg8::StaticOrder S; S.init(M, 4096, G, (int)blockIdx.x);
          pg8::EpiInProj E{QK, (bf16*)(ws + WS_KF), Gt, rope, kpart};
          pg8::gemm_phase<pg8::EpiInProj, true>(lds, g, S, E); }
        REP(1) { pg8::Gemm g{(const bf16*)(wl + WO_VT), XN, 1024, M, 1024}; pg8::StaticOrder S; S.init(1024, M, G, (int)blockIdx.x);
          pg8::EpiVt E{Vt};
          pg8::gemm_phase<pg8::EpiVt, true>(lds, g, S, E); }
        GRID_BAR();
        REP(2) attn_phase_v1(a, lds, G);
        GRID_BAR();
        REP(3) { pg8::Gemm g{O, (const bf16*)(wl + WO_BR), M, 1024, 1024}; pg8::StaticOrder S; S.init(M, 1024, G, (int)blockIdx.x);
          pg8::EpiMerged E{Gt, MG};
          pg8::gemm_phase<pg8::EpiMerged, false>(lds, g, S, E); }
        GRID_BAR();
        REP(4) { pg8::Gemm g{MG, (const bf16*)(wl + WO_OUT), M, 1024, 1024}; pg8::StaticOrder S; S.init(M, 1024, G, (int)blockIdx.x);
          pg8::EpiResid E{Xres, Y, ALPHA};
          pg8::gemm_phase<pg8::EpiResid, false>(lds, g, S, E); }
        GRID_BAR();
        REP(5) ln_phase(Y, a.in[5] + (size_t)l * D, a.in[6] + (size_t)l * D, a.out, XN, gw, NGW, lane);
        GRID_BAR();
        REP(6) { pg8::Gemm g{XN, (const bf16*)(wl + WO_GU), M, 2 * DFF, 1024}; pg8::StaticOrder S; S.init(M, 2 * DFF, G, (int)blockIdx.x);
          pg8::EpiSwiglu E{H};
          pg8::gemm_phase<pg8::EpiSwiglu, true>(lds, g, S, E); }
        GRID_BAR();
        REP(7) { pg8::Gemm g{H, (const bf16*)(wl + WO_DN), M, 1024, DFF}; pg8::StaticOrder S; S.init(M, 1024, G, (int)blockIdx.x);
          pg8::EpiResid E{a.out, Y2, ALPHA};
          pg8::gemm_phase<pg8::EpiResid, false>(lds, g, S, E); }
        GRID_BAR();
        REP(8) ln_phase(Y2, a.in[10] + (size_t)l * D, a.in[11] + (size_t)l * D, a.out, XN, gw, NGW, lane);
        if (l + 1 < DEPTH) GRID_BAR();
        if ((PROBE_REP >> 9) & 1) for (int k = 0; k < 8; ++k) GRID_BAR();
    }
}

extern "C" void kernel_launch(void* const* d_in, const int* in_sizes, int n_in, void* d_out, int out_size, void* d_ws, size_t ws_size, hipStream_t stream) {
    static int grid = 0;
    if (grid == 0) {
        if (n_in != 12 || in_sizes[0] != M * D || out_size != M * D || ws_size < WS_END) { fprintf(stderr, "kernel_launch: unexpected problem shape (n_in %d, ws %zu); nothing launched\n", n_in, ws_size); grid = -1; return; }
        int dev = 0, cus = 0, per_cu = 0;
        if (hipGetDevice(&dev) != hipSuccess || hipDeviceGetAttribute(&cus, hipDeviceAttributeMultiprocessorCount, dev) != hipSuccess) { grid = -1; return; }
        if (hipFuncSetAttribute((const void*)fwd_megakernel, hipFuncAttributeMaxDynamicSharedMemorySize, LDS_BYTES) != hipSuccess) { fprintf(stderr, "kernel_launch: hipFuncSetAttribute failed\n"); grid = -1; return; }
        if (hipOccupancyMaxActiveBlocksPerMultiprocessor(&per_cu, (const void*)fwd_megakernel, NTHREADS, LDS_BYTES) != hipSuccess || per_cu < 1) per_cu = 1;
        (void)hipGetLastError();
        grid = cus;
        (void)per_cu;
    }
    if (grid < 0) return;
    if (hipMemsetAsync((char*)d_ws + WS_BAR, 0, BAR_ZERO_BYTES, stream) != hipSuccess) { fprintf(stderr, "kernel_launch: memset of the barrier words failed\n"); return; }
    Args a{};
    for (int i = 0; i < 12; ++i) a.in[i] = (const float*)d_in[i];
    a.out = (float*)d_out; a.ws = (unsigned char*)d_ws;
    void* args[] = {&a};
    hipError_t e = hipLaunchCooperativeKernel((const void*)fwd_megakernel, dim3(grid), dim3(NTHREADS), args, LDS_BYTES, stream);
    if (e != hipSuccess) fprintf(stderr, "cooperative launch failed: %s (grid %d)\n", hipGetErrorString(e), grid);
}
```
